# Optimizing an MI355X kernel written in HIP

```python
import math
import jax
import jax.numpy as jnp
from jax import lax
import numpy as np

D_MODEL = 1024
BATCH = 8
SEQ = 2048
DEPTH = 4

GRID_W = 64
CTX_LEN = 256
RMS_EPS = 1e-6
N_MOD = 9
FFN_HIDDEN = 2816

GM_GROUPS = 4
GM_WIDTH = 512
GM_CHUNK = 128

DN_HEADS = 4
DN_HEAD_DIM = 128
DN_WIDTH = DN_HEADS * DN_HEAD_DIM
DN_CONV = 5
DN_CHUNK = 64

MLA_HEADS = 8
MLA_NOPE = 64
MLA_ROPE = 32
MLA_QK = MLA_NOPE + MLA_ROPE
MLA_V = 64
MLA_WIDTH = MLA_HEADS * MLA_V
MLA_Q_LORA = 384
MLA_KV_LORA = 256
Q_BLOCK = 128
ROPE_BASE = 10000.0

N_BRANCH = 3
IN_SPLITS = (2 * GM_WIDTH, 3 * DN_WIDTH, DN_WIDTH, 4 * DN_HEADS, MLA_Q_LORA, MLA_KV_LORA + MLA_ROPE, N_BRANCH * D_MODEL)
IN_WIDTH = sum(IN_SPLITS)

kernel_name = 'hybrid_gmlp_deltanet_mla_prefix_dit'


def rms_norm(x, w):
    x32 = x.astype(jnp.float32)
    y = x32 * lax.rsqrt(jnp.mean(x32 * x32, axis=-1, keepdims=True) + RMS_EPS)
    return y.astype(x.dtype) * w


def layer_norm(x, w):
    x32 = x.astype(jnp.float32)
    mu = jnp.mean(x32, axis=-1, keepdims=True)
    xc = x32 - mu
    y = xc * lax.rsqrt(jnp.mean(xc * xc, axis=-1, keepdims=True) + RMS_EPS)
    return y.astype(x.dtype) * w


def l2_normalize(x):
    return x * lax.rsqrt(jnp.sum(x * x, axis=-1, keepdims=True) + RMS_EPS)


def modulate(x, shift, scale):
    return x * (1.0 + scale) + shift


def swiglu(h, w_gu, w_down):
    g, u = jnp.split(h @ w_gu, 2, axis=-1)
    return (jax.nn.silu(g) * u) @ w_down


def ada_ffn_half(h, shift, scale, gate, norm_w, w_gu, w_down):
    return h + 0.5 * gate * swiglu(modulate(rms_norm(h, norm_w), shift, scale), w_gu, w_down)


def split_in(p):
    offsets = np.cumsum(IN_SPLITS)[:-1].tolist()
    return jnp.split(p, offsets, axis=-1)


def axial_rope_tables(n_tokens, dtype):
    rows = n_tokens // GRID_W
    row = jnp.repeat(jnp.arange(rows), GRID_W).astype(jnp.float32)
    col = jnp.tile(jnp.arange(GRID_W), rows).astype(jnp.float32)
    half = MLA_ROPE // 2
    inv_freq = 1.0 / (ROPE_BASE ** (jnp.arange(0, half, 2, dtype=jnp.float32) / half))
    ang_r = row[:, None] * inv_freq
    ang_c = col[:, None] * inv_freq
    ang = jnp.concatenate([ang_r, ang_r, ang_c, ang_c], axis=-1)
    return jnp.cos(ang).astype(dtype), jnp.sin(ang).astype(dtype)


def rotate_half(y):
    y1, y2 = jnp.split(y, 2, axis=-1)
    return jnp.concatenate([-y2, y1], axis=-1)


def apply_axial_rope(t, cos, sin):
    tr, tc = jnp.split(t, 2, axis=-1)
    rot = jnp.concatenate([rotate_half(tr), rotate_half(tc)], axis=-1)
    return t * cos[None, :, None, :] + rot * sin[None, :, None, :]


def rope_tail(t, rope):
    if rope is None:
        return t
    cos, sin = rope
    return jnp.concatenate([t[..., :MLA_NOPE], apply_axial_rope(t[..., MLA_NOPE:], cos, sin)], axis=-1)


def chunk_gmlp_branch(z, ln_w, w_s, b_s):
    z = jax.nn.gelu(z)
    u, v = jnp.split(z, 2, axis=-1)
    v = layer_norm(v, ln_w)
    b, n, _ = v.shape
    v = v.reshape(b, n // GM_CHUNK, GM_CHUNK, GM_GROUPS, GM_WIDTH // GM_GROUPS)
    s = jnp.einsum('gpq,bnqgc->bnpgc', w_s, v) + b_s.T[None, None, :, :, None]
    return u * s.reshape(b, n, GM_WIDTH)


def centred_depthwise_conv(x, w):
    ch = x.shape[-1]
    return lax.conv_general_dilated(
        x, w[:, None, :].astype(x.dtype), window_strides=(1,),
        padding=[(DN_CONV // 2, DN_CONV // 2)],
        dimension_numbers=('NWC', 'WIO', 'NWC'), feature_group_count=ch)


def delta_prepare(qkv, ab, conv_w, a_log, dt_bias):
    b, n, _ = qkv.shape
    qkv = jax.nn.silu(centred_depthwise_conv(qkv, conv_w)).astype(jnp.float32)
    q, k, v = jnp.split(qkv, 3, axis=-1)

    def heads(y):
        return y.reshape(b, n, DN_HEADS, DN_HEAD_DIM).transpose(0, 2, 1, 3)

    q = l2_normalize(heads(q))
    k = l2_normalize(heads(k))
    v = heads(v)
    ab = ab.astype(jnp.float32).reshape(b, n, 2, 2, DN_HEADS)
    a, bpre = ab[:, :, 0], ab[:, :, 1]
    g = -jnp.exp(a_log.astype(jnp.float32)) * jax.nn.softplus(a + dt_bias.astype(jnp.float32))
    beta = jax.nn.sigmoid(bpre)
    return q, k, v, g.transpose(2, 0, 3, 1), beta.transpose(2, 0, 3, 1)


def gated_delta_chunked(q, k, v, g, beta, s0):
    b, h, n, dk = q.shape
    dv = v.shape[-1]
    nc = n // DN_CHUNK
    q = (q * dk ** -0.5).reshape(b, h, nc, DN_CHUNK, dk)
    k = k.reshape(b, h, nc, DN_CHUNK, dk)
    v = v.reshape(b, h, nc, DN_CHUNK, dv)
    beta = beta.reshape(b, h, nc, DN_CHUNK)
    gam = jnp.cumsum(g.reshape(b, h, nc, DN_CHUNK), axis=-1)
    incl = jnp.tril(jnp.ones((DN_CHUNK, DN_CHUNK), dtype=bool))
    strict = jnp.tril(jnp.ones((DN_CHUNK, DN_CHUNK), dtype=bool), k=-1)
    diff = gam[..., :, None] - gam[..., None, :]
    decay = jnp.where(incl, jnp.exp(jnp.where(incl, diff, 0.0)), 0.0)
    kb = k * beta[..., None]
    m = jnp.where(strict, jnp.einsum('bhncd,bhnsd->bhncs', kb, k) * decay, 0.0)
    eye = jnp.eye(DN_CHUNK, dtype=jnp.float32)
    t_inv = lax.linalg.triangular_solve(eye + m, jnp.broadcast_to(eye, m.shape), left_side=True, lower=True)
    u = jnp.einsum('bhncs,bhnse->bhnce', t_inv, v * beta[..., None])
    w = jnp.einsum('bhncs,bhnsd->bhncd', t_inv, kb * jnp.exp(gam)[..., None])
    qk = jnp.einsum('bhncd,bhnsd->bhncs', q, k) * decay

    def step(s, xs):
        q_c, k_c, u_c, w_c, qk_c, gam_c = xs
        v_new = u_c - jnp.einsum('bhcd,bhde->bhce', w_c, s)
        o = (jnp.einsum('bhcd,bhde->bhce', q_c * jnp.exp(gam_c)[..., None], s)
             + jnp.einsum('bhcs,bhse->bhce', qk_c, v_new))
        g_last = gam_c[..., -1]
        s = (s * jnp.exp(g_last)[..., None, None]
             + jnp.einsum('bhcd,bhce->bhde', k_c * jnp.exp(g_last[..., None] - gam_c)[..., None], v_new))
        return s, o

    xs = tuple(jnp.moveaxis(a, 2, 0) for a in (q, k, u, w, qk, gam))
    s_final, o = lax.scan(step, s0, xs)
    o = jnp.moveaxis(o, 0, 2).reshape(b, h, n, dv)
    return o, s_final


def _orient(t, reverse):
    return jnp.flip(t, axis=2) if reverse else t


def bidirectional_delta(qkv_c, ab_c, qkv_x, ab_x, conv_w, a_log, dt_bias):
    qc, kc, vc, gc, bc = delta_prepare(qkv_c, ab_c, conv_w, a_log, dt_bias)
    qx, kx, vx, gx, bx = delta_prepare(qkv_x, ab_x, conv_w, a_log, dt_bias)
    s_zero = jnp.zeros((qx.shape[0], DN_HEADS, DN_HEAD_DIM, DN_HEAD_DIM), jnp.float32)
    outs_c, outs_x = [], []
    for d in range(2):
        rev = d == 1
        oc, s_ctx = gated_delta_chunked(_orient(qc, rev), _orient(kc, rev), _orient(vc, rev),
                                        _orient(gc[d], rev), _orient(bc[d], rev), s_zero)
        ox, _ = gated_delta_chunked(_orient(qx, rev), _orient(kx, rev), _orient(vx, rev),
                                    _orient(gx[d], rev), _orient(bx[d], rev), s_ctx)
        outs_c.append(_orient(oc, rev))
        outs_x.append(_orient(ox, rev))
    return outs_c[0] + outs_c[1], outs_x[0] + outs_x[1]


def delta_output(o, z, norm_w):
    b, _, n, _ = o.shape
    o = rms_norm(o.transpose(0, 2, 1, 3), norm_w).astype(z.dtype)
    return (o * jax.nn.silu(z.reshape(b, n, DN_HEADS, DN_HEAD_DIM))).reshape(b, n, DN_WIDTH)


def mla_q(cq, q_norm, w_uq, qk_norm_q, rope):
    b, n, _ = cq.shape
    q = (rms_norm(cq, q_norm) @ w_uq).reshape(b, n, MLA_HEADS, MLA_QK)
    return rope_tail(rms_norm(q, qk_norm_q), rope)


def mla_kv(ckv_in, kv_norm, w_ukv, qk_norm_k, rope):
    b, n, _ = ckv_in.shape
    ckv, k_rope = jnp.split(ckv_in, [MLA_KV_LORA], axis=-1)
    kv = (rms_norm(ckv, kv_norm) @ w_ukv).reshape(b, n, MLA_HEADS, MLA_NOPE + MLA_V)
    k_nope, v = jnp.split(kv, [MLA_NOPE], axis=-1)
    k = jnp.concatenate([k_nope, jnp.broadcast_to(k_rope[:, :, None, :], (b, n, MLA_HEADS, MLA_ROPE))], axis=-1)
    return rope_tail(rms_norm(k, qk_norm_k), rope), v


def attend(q, k, v):
    s = jnp.einsum('bqhd,bkhd->bhqk', q, k, preferred_element_type=jnp.float32) * MLA_QK ** -0.5
    p = jax.nn.softmax(s, axis=-1).astype(v.dtype)
    return jnp.einsum('bhqk,bkhd->bqhd', p, v)


def latent_attention(q, k, v, k_ctx, v_ctx):
    b, n, h, d = q.shape
    k_all = jnp.concatenate([k, k_ctx], axis=1)
    v_all = jnp.concatenate([v, v_ctx], axis=1)
    qb = q.reshape(b, n // Q_BLOCK, Q_BLOCK, h, d).transpose(1, 0, 2, 3, 4)
    o = lax.map(lambda qq: attend(qq, k_all, v_all), qb)
    return o.transpose(1, 0, 2, 3, 4).reshape(b, n, MLA_WIDTH)


def merge_branches(ya, yb, yc, gates, w_a, w_b, w_c, w_o):
    ga, gb, gc = jnp.split(gates, N_BRANCH, axis=-1)
    m = (jax.nn.sigmoid(ga) * (ya @ w_a) + jax.nn.sigmoid(gb) * (yb @ w_b)
         + jax.nn.sigmoid(gc) * (yc @ w_c))
    return m @ w_o


def token_mixing(uc, ux, rope, w_in, gm_ln, gm_ws, gm_bs, dn_conv, dn_a_log, dn_dt_bias, dn_out_norm,
                 mla_q_norm, mla_w_uq, mla_kv_norm, mla_w_ukv, mla_qk_norm_q, mla_qk_norm_k,
                 w_branch_gm, w_branch_dn, w_branch_mla, w_out, need_ctx):
    gm_c, qkv_c, z_c, ab_c, cq_c, ckv_c, gate_c = split_in(uc @ w_in)
    gm_x, qkv_x, z_x, ab_x, cq_x, ckv_x, gate_x = split_in(ux @ w_in)
    ya_x = chunk_gmlp_branch(gm_x, gm_ln, gm_ws, gm_bs)
    o_c, o_x = bidirectional_delta(qkv_c, ab_c, qkv_x, ab_x, dn_conv, dn_a_log, dn_dt_bias)
    yb_x = delta_output(o_x, z_x, dn_out_norm)
    k_c, v_c = mla_kv(ckv_c, mla_kv_norm, mla_w_ukv, mla_qk_norm_k, None)
    k_x, v_x = mla_kv(ckv_x, mla_kv_norm, mla_w_ukv, mla_qk_norm_k, rope)
    q_x = mla_q(cq_x, mla_q_norm, mla_w_uq, mla_qk_norm_q, rope)
    yc_x = latent_attention(q_x, k_x, v_x, k_c, v_c)
    y_x = merge_branches(ya_x, yb_x, yc_x, gate_x, w_branch_gm, w_branch_dn, w_branch_mla, w_out)
    if not need_ctx:
        return None, y_x
    ya_c = chunk_gmlp_branch(gm_c, gm_ln, gm_ws, gm_bs)
    yb_c = delta_output(o_c, z_c, dn_out_norm)
    q_c = mla_q(cq_c, mla_q_norm, mla_w_uq, mla_qk_norm_q, None)
    yc_c = attend(q_c, k_c, v_c).reshape(q_c.shape[0], q_c.shape[1], MLA_WIDTH)
    y_c = merge_branches(ya_c, yb_c, yc_c, gate_c, w_branch_gm, w_branch_dn, w_branch_mla, w_out)
    return y_c, y_x


def setup_inputs(seed: int = 0) -> dict:
    key = jax.random.key(seed)
    keys = iter(jax.random.split(key, 48))
    f32 = jnp.float32
    L, D = DEPTH, D_MODEL

    def nrm(shape, scale):
        return jax.random.normal(next(keys), shape, f32) * scale

    def gain(shape):
        return 1.0 + 0.05 * jax.random.normal(next(keys), shape, f32)

    dt = jnp.exp(jax.random.uniform(next(keys), (L, 2, DN_HEADS), f32, math.log(1e-3), math.log(1e-1)))
    a_log = jnp.log(jax.random.uniform(next(keys), (L, 2, DN_HEADS), f32, 1.0, 16.0))
    return {
        'x': nrm((BATCH, SEQ, D), 1.0),
        'c': nrm((BATCH, D), 1.0),
        'ctx': nrm((BATCH, CTX_LEN, D), 1.0),
        'c_ctx': nrm((D,), 1.0),
        'ada_w': nrm((L, D, N_MOD * D), D ** -0.5),
        'ada_b': nrm((L, N_MOD * D), 0.02),
        'ffn1_norm': gain((L, D)),
        'ffn1_w_gu': nrm((L, D, 2 * FFN_HIDDEN), D ** -0.5),
        'ffn1_w_down': nrm((L, FFN_HIDDEN, D), FFN_HIDDEN ** -0.5),
        'mix_norm': gain((L, D)),
        'w_in': nrm((L, D, IN_WIDTH), D ** -0.5),
        'gm_ln': gain((L, GM_WIDTH)),
        'gm_ws': nrm((L, GM_GROUPS, GM_CHUNK, GM_CHUNK), GM_CHUNK ** -0.5),
        'gm_bs': 1.0 + nrm((L, GM_GROUPS, GM_CHUNK), 0.1),
        'dn_conv': nrm((L, DN_CONV, 3 * DN_WIDTH), DN_CONV ** -0.5),
        'dn_a_log': a_log,
        'dn_dt_bias': jnp.log(jnp.expm1(dt)),
        'dn_out_norm': gain((L, DN_HEAD_DIM)),
        'mla_q_norm': gain((L, MLA_Q_LORA)),
        'mla_w_uq': nrm((L, MLA_Q_LORA, MLA_HEADS * MLA_QK), MLA_Q_LORA ** -0.5),
        'mla_kv_norm': gain((L, MLA_KV_LORA)),
        'mla_w_ukv': nrm((L, MLA_KV_LORA, MLA_HEADS * (MLA_NOPE + MLA_V)), MLA_KV_LORA ** -0.5),
        'mla_qk_norm_q': gain((L, MLA_QK)),
        'mla_qk_norm_k': gain((L, MLA_QK)),
        'w_branch_gm': nrm((L, GM_WIDTH, D), GM_WIDTH ** -0.5),
        'w_branch_dn': nrm((L, DN_WIDTH, D), DN_WIDTH ** -0.5),
        'w_branch_mla': nrm((L, MLA_WIDTH, D), MLA_WIDTH ** -0.5),
        'w_out': nrm((L, D, D), D ** -0.5),
        'ffn2_norm': gain((L, D)),
        'ffn2_w_gu': nrm((L, D, 2 * FFN_HIDDEN), D ** -0.5),
        'ffn2_w_down': nrm((L, FFN_HIDDEN, D), FFN_HIDDEN ** -0.5),
    }


def reference(x, c, ctx, c_ctx, ada_w, ada_b, ffn1_norm, ffn1_w_gu, ffn1_w_down, mix_norm, w_in,
              gm_ln, gm_ws, gm_bs, dn_conv, dn_a_log, dn_dt_bias, dn_out_norm,
              mla_q_norm, mla_w_uq, mla_kv_norm, mla_w_ukv, mla_qk_norm_q, mla_qk_norm_k,
              w_branch_gm, w_branch_dn, w_branch_mla, w_out, ffn2_norm, ffn2_w_gu, ffn2_w_down):
    rope = axial_rope_tables(x.shape[1], x.dtype)
    hx, hc = x, ctx
    for l in range(DEPTH):
        need_ctx = l < DEPTH - 1
        mx = jnp.split((jax.nn.silu(c) @ ada_w[l] + ada_b[l])[:, None, :], N_MOD, axis=-1)
        mc = jnp.split(jax.nn.silu(c_ctx) @ ada_w[l] + ada_b[l], N_MOD, axis=-1)
        hc = ada_ffn_half(hc, mc[0], mc[1], mc[2], ffn1_norm[l], ffn1_w_gu[l], ffn1_w_down[l])
        hx = ada_ffn_half(hx, mx[0], mx[1], mx[2], ffn1_norm[l], ffn1_w_gu[l], ffn1_w_down[l])
        uc = modulate(rms_norm(hc, mix_norm[l]), mc[3], mc[4])
        ux = modulate(rms_norm(hx, mix_norm[l]), mx[3], mx[4])
        yc, yx = token_mixing(uc, ux, rope, w_in[l], gm_ln[l], gm_ws[l], gm_bs[l], dn_conv[l],
                              dn_a_log[l], dn_dt_bias[l], dn_out_norm[l], mla_q_norm[l], mla_w_uq[l],
                              mla_kv_norm[l], mla_w_ukv[l], mla_qk_norm_q[l], mla_qk_norm_k[l],
                              w_branch_gm[l], w_branch_dn[l], w_branch_mla[l], w_out[l], need_ctx)
        hx = hx + mx[5] * yx
        hx = ada_ffn_half(hx, mx[6], mx[7], mx[8], ffn2_norm[l], ffn2_w_gu[l], ffn2_w_down[l])
        if need_ctx:
            hc = hc + mc[5] * yc
            hc = ada_ffn_half(hc, mc[6], mc[7], mc[8], ffn2_norm[l], ffn2_w_gu[l], ffn2_w_down[l])
    return hx
```

```cpp
#include <hip/hip_runtime.h>
#include <hip/hip_cooperative_groups.h>
#include <cstdio>
namespace cg = cooperative_groups;
namespace pg8 {
#define PG8_LAS __attribute__((address_space(3)))
typedef unsigned short bf16_t;
typedef short bf16x8 __attribute__((ext_vector_type(8)));
typedef float f32x4 __attribute__((ext_vector_type(4)));
typedef unsigned u32x4 __attribute__((ext_vector_type(4)));
constexpr int BM = 256, BK = 64, HALF = 128, HTB = HALF * BK * 2  , STAGE_BYTES = 8 * HTB, NXCD = 8, WGM = 8;

__host__ __device__ __forceinline__ int lds_byte(int r, int c) { const int st = (r >> 4) * 2 + (c >> 5), rr = r & 15, cc = c & 31, ob = rr * 64 + cc * 2; return st * 1024 + (ob ^ (((ob >> 9) & 1) << 5)); }
__host__ __device__ __forceinline__ void stage_rc(int b, int& R, int& C) { const int st = b / 1024, sb = b % 1024, swz = sb ^ (((sb >> 9) & 1) << 5); R = (st >> 1) * 16 + swz / 64; C = (st & 1) * 32 + (swz % 64) / 2; }
__host__ __device__ __forceinline__ int perm32(int rho) { const int n = rho >> 4, i = rho & 15; return 8 * (i >> 2) + 4 * n + (i & 3); }

struct Unit { int pm, pn; };
struct Gemm { const bf16_t* A; const bf16_t* Bt; int M, N, K; };

struct StaticOrder {
    int nM, nN, nwg, G, c;
    __host__ __device__ void init(int M, int N, int G_, int c_) { nM = M / BM; nN = N / BM; nwg = nM * nN; G = G_; c = c_; }
    __host__ __device__ bool next(int i, Unit& u) const {
        const long L = (long)i * G + c; if (L >= nwg) return false;
        int wgid = (int)L; { const int q = nwg / NXCD, r = nwg % NXCD, xcd = wgid % NXCD, off = wgid / NXCD; wgid = (xcd < r ? xcd * (q + 1) : r * (q + 1) + (xcd - r) * q) + off; }
        const int nig = WGM * nN, gid = wgid / nig, fm = gid * WGM, gsz = (nM - fm) < WGM ? (nM - fm) : WGM;
        u.pm = fm + ((wgid % nig) % gsz); u.pn = (wgid % nig) / gsz; return true;
    }
    __device__ __forceinline__ void a_ready(const Unit&) const {}
    __device__ __forceinline__ void done(const Unit&) const {}
};
__device__ __forceinline__ unsigned cvt_pk_bf16(float lo, float hi) { unsigned r; asm volatile("v_cvt_pk_bf16_f32 %0, %1, %2" : "=v"(r) : "v"(lo), "v"(hi)); return r; }
typedef float f32x2 __attribute__((ext_vector_type(2)));
template <class Epi, class Sched, bool STAMP = false>
__device__ __forceinline__ void gemm_phase(PG8_LAS unsigned char* lds, const Gemm g, const Sched& S, const Epi& E, unsigned long long* stamps) {
    int tid_ = threadIdx.x; asm volatile("" : "+v"(tid_)); const int tid = tid_, wid = __builtin_amdgcn_readfirstlane(tid >> 6), lane = tid & 63, wr = wid >> 2, wc = wid & 3, fr = lane & 15, fq = lane >> 4;
    const int K = g.K, nt = K / BK;
    int ts_lo = 0, ts_hi = 0, nts = 0; const unsigned long long rt_entry = STAMP ? (unsigned long long)wall_clock64() : 0ull;
#define PG8_STAMP() do { if (STAMP && wid == 0 && nts < 64) { const unsigned long long _c = (unsigned long long)clock64(); \
        ts_lo = (lane == nts) ? (int)(unsigned)_c : ts_lo; ts_hi = (lane == nts) ? (int)(unsigned)(_c >> 32) : ts_hi; ++nts; } } while (0)
    PG8_STAMP();
    unsigned voffA[2], voffB[2];
#pragma unroll
    for (int i = 0; i < 2; ++i) { int R, C; stage_rc(tid * 16 + i * 8192, R, C); const int Rb = Epi::PERM ? ((R & ~31) + perm32(R & 31)) : R;
        voffA[i] = (unsigned)(R * K + C) * 2u; voffB[i] = (unsigned)(Rb * K + C) * 2u; }
    const size_t kstep = (size_t)(BK * 2);
    const size_t hstep = (size_t)HALF * K * 2;
    const size_t tstep = 2 * hstep;
    const unsigned ldsw = (unsigned)wid * 1024u;
    const int aoff = lds_byte(wr * 64 + fr, fq * 8), boff = lds_byte(wc * 32 + fr, fq * 8);
#define PG8_SA(b, h) (((b) * 2 + (h)) * HTB)
#define PG8_SB(b, h) ((4 + (b) * 2 + (h)) * HTB)
#define PG8_STAGE(bufoff, gbase, voff) do { _Pragma("unroll") for (int _i = 0; _i < 2; ++_i) \
        __builtin_amdgcn_global_load_lds((const unsigned*)((const char*)(gbase) + (voff)[_i]), (PG8_LAS unsigned*)(lds + (bufoff) + ldsw + _i * 8192), 16, 0, 0); } while (0)
#define PG8_LDA(dst, b, h) do { _Pragma("unroll") for (int m = 0; m < 4; ++m) _Pragma("unroll") for (int k = 0; k < 2; ++k) dst[m][k] = *(const PG8_LAS bf16x8*)(lds + PG8_SA(b, h) + aoff + m * 2048 + k * 1024); } while (0)
#define PG8_LDB(dst, b, h) do { _Pragma("unroll") for (int n = 0; n < 2; ++n) _Pragma("unroll") for (int k = 0; k < 2; ++k) dst[n][k] = *(const PG8_LAS bf16x8*)(lds + PG8_SB(b, h) + boff + n * 2048 + k * 1024); } while (0)
#define PG8_MMA(ai, bj, At, Bt) do { __builtin_amdgcn_s_setprio(1); _Pragma("unroll") for (int m = 0; m < 4; ++m) _Pragma("unroll") for (int n = 0; n < 2; ++n) _Pragma("unroll") for (int k = 0; k < 2; ++k) \
        acc[ai][bj][m][n] = __builtin_amdgcn_mfma_f32_16x16x32_bf16(Bt[n][k], At[m][k], acc[ai][bj][m][n], 0, 0, 0); __builtin_amdgcn_s_setprio(0); } while (0)
#define PG8_WAIT_V(n) asm volatile("s_waitcnt vmcnt(" #n ")" ::: "memory")
#define PG8_WAIT_L(n) asm volatile("s_waitcnt lgkmcnt(" #n ")" ::: "memory")
#define PG8_BAR __builtin_amdgcn_s_barrier()
#define PG8_SCHED __builtin_amdgcn_sched_barrier(0)
    Unit cur, nxt; int ui = 0;
    if (!S.next(0, cur)) return;
    f32x4 acc[2][2][4][2];
#pragma unroll
    for (int a = 0; a < 2; ++a)
#pragma unroll
        for (int b = 0; b < 2; ++b)
#pragma unroll
            for (int m = 0; m < 4; ++m)
#pragma unroll
                for (int n = 0; n < 2; ++n) acc[a][b][m][n] = (f32x4){0.f, 0.f, 0.f, 0.f};
    bf16x8 At[4][2], B0[2][2], B1[2][2];
    const char* cA = (const char*)g.A + (size_t)cur.pm * tstep; const char* cB = (const char*)g.Bt + (size_t)cur.pn * tstep;
    S.a_ready(cur);
    PG8_STAGE(PG8_SB(0, 0), cB, voffB); PG8_STAGE(PG8_SA(0, 0), cA, voffA); PG8_STAGE(PG8_SB(0, 1), cB + hstep, voffB); PG8_STAGE(PG8_SA(0, 1), cA + hstep, voffA);
    if (wr == 1) PG8_BAR;
    PG8_WAIT_V(4); PG8_BAR;
    PG8_STAGE(PG8_SB(1, 0), cB + kstep, voffB); PG8_STAGE(PG8_SA(1, 0), cA + kstep, voffA); PG8_STAGE(PG8_SB(1, 1), cB + hstep + kstep, voffB);
    PG8_WAIT_V(6); PG8_BAR;
    PG8_STAMP();
    for (;;) {
        const bool has_next = S.next(ui + 1, nxt);
        const char* nA = has_next ? (const char*)g.A + (size_t)nxt.pm * tstep : cA; const char* nB = has_next ? (const char*)g.Bt + (size_t)nxt.pn * tstep : cB;
        for (int t = 0; t < nt; t += 2) {
            const bool last = (t == nt - 2);
            const char* a1 = cA + (size_t)(t + 1) * kstep;
            const char* a2 = last ? nA : cA + (size_t)(t + 2) * kstep; const char* b2 = last ? nB : cB + (size_t)(t + 2) * kstep;
            const char* a3 = a2 + kstep; const char* b3 = b2 + kstep;
            if (last && has_next) S.a_ready(nxt);
            PG8_LDB(B0, 0, 0); PG8_SCHED; PG8_LDA(At, 0, 0); PG8_STAGE(PG8_SA(1, 1), a1 + hstep, voffA);
            PG8_WAIT_L(8); PG8_BAR; PG8_WAIT_L(0); PG8_MMA(0, 0, At, B0); PG8_BAR; PG8_SCHED;
            PG8_LDB(B1, 0, 1); PG8_STAGE(PG8_SB(0, 0), b2, voffB);
            PG8_BAR; PG8_WAIT_L(0); PG8_MMA(0, 1, At, B1); PG8_BAR;
            PG8_LDA(At, 0, 1); PG8_STAGE(PG8_SA(0, 0), a2, voffA);
            PG8_BAR; PG8_WAIT_L(0); PG8_MMA(1, 0, At, B0); PG8_BAR; PG8_SCHED;
            PG8_STAGE(PG8_SB(0, 1), b2 + hstep, voffB);
            PG8_WAIT_V(6); PG8_BAR; PG8_MMA(1, 1, At, B1); PG8_BAR;
            PG8_LDB(B0, 1, 0); PG8_SCHED; PG8_LDA(At, 1, 0); PG8_STAGE(PG8_SA(0, 1), a2 + hstep, voffA);
            PG8_WAIT_L(8); PG8_BAR; PG8_WAIT_L(0); PG8_MMA(0, 0, At, B0); PG8_BAR; PG8_SCHED;
            PG8_LDB(B1, 1, 1); PG8_STAGE(PG8_SB(1, 0), b3, voffB);
            PG8_BAR; PG8_WAIT_L(0); PG8_MMA(0, 1, At, B1); PG8_BAR;
            PG8_LDA(At, 1, 1); PG8_STAGE(PG8_SA(1, 0), a3, voffA);
            PG8_BAR; PG8_WAIT_L(0); PG8_MMA(1, 0, At, B0); PG8_BAR; PG8_SCHED;
            PG8_STAGE(PG8_SB(1, 1), b3 + hstep, voffB);
            PG8_WAIT_V(6); PG8_BAR; PG8_MMA(1, 1, At, B1); PG8_BAR;
        }
        PG8_STAMP();
        if constexpr (!Epi::AFTER_DRAIN) { E(acc, cur, wr, wc, fr, fq); S.done(cur); }
        PG8_STAMP();
        if (!has_next) break;
#pragma unroll
        for (int a = 0; a < 2; ++a)
#pragma unroll
            for (int b = 0; b < 2; ++b)
#pragma unroll
                for (int m = 0; m < 4; ++m)
#pragma unroll
                    for (int n = 0; n < 2; ++n) acc[a][b][m][n] = (f32x4){0.f, 0.f, 0.f, 0.f};
        cur = nxt; cA = nA; cB = nB; ++ui;
    }
    PG8_WAIT_V(0);
    if (wr == 0) PG8_BAR;
    PG8_BAR;
    if constexpr (Epi::AFTER_DRAIN) { E.fused(acc, cur, wr, wc, fr, fq, lds, wid, lane); S.done(cur); }
    PG8_STAMP();
    if (STAMP && wid == 0) { stamps[lane] = lane < nts ? (((unsigned long long)(unsigned)ts_hi << 32) | (unsigned)ts_lo) : 0ull;
        if (lane == 62) stamps[62] = rt_entry; if (lane == 63) stamps[63] = (unsigned long long)wall_clock64(); }
#undef PG8_STAMP
#undef PG8_SA
#undef PG8_SB
#undef PG8_STAGE
#undef PG8_LDA
#undef PG8_LDB
#undef PG8_MMA
#undef PG8_WAIT_V
#undef PG8_WAIT_L
#undef PG8_BAR
#undef PG8_SCHED
}
}
#define XB_TMO      128
#define XB_XCNT(j)  (256  + 64 * (j))
#define XB_XSUB(j)  (1280 + 64 * (j))
#define XB_XGEN(j)  (2304 + 64 * (j))
#define XB_TOP      3328
#define XB_TOPGEN   3392
#define XCD_BAR_WORDS 3456
#define XB_SPIN_CAP (1u << 18)
#define LAS __attribute__((address_space(3)))

__device__ __forceinline__ unsigned xb_ld(unsigned* p)              { return __hip_atomic_load(p, __ATOMIC_RELAXED, __HIP_MEMORY_SCOPE_AGENT); }
__device__ __forceinline__ unsigned xb_add(unsigned* p, unsigned v) { return __hip_atomic_fetch_add(p, v, __ATOMIC_RELAXED, __HIP_MEMORY_SCOPE_AGENT); }
__device__ __forceinline__ unsigned xb_xcc_id() { return (unsigned)__builtin_amdgcn_s_getreg((3 << 11) | 20) & 0xFu; }
#define XB_SPIN(cond, bar) do { unsigned _sp = 0; while (cond) { __builtin_amdgcn_s_sleep(1); \
    if ((++_sp & 255u) == 0u) { if (xb_ld(&(bar)[XB_TMO])) break; if (_sp > XB_SPIN_CAP) { atomicAdd(&(bar)[XB_TMO], 1u); break; } } } } while (0)

struct XcdBarrier {
    unsigned* bar; unsigned x;
    volatile LAS unsigned* st;
};

__device__ __forceinline__ XcdBarrier xcd_barrier_post(unsigned* bar, volatile LAS unsigned* st) {
    XcdBarrier b; b.bar = bar; b.x = xb_xcc_id(); b.st = st;
    if (threadIdx.x == 0) (void)xb_add(&bar[XB_XCNT(b.x)], 1u);
    return b;
}
__device__ __forceinline__ void xcd_barrier_complete(unsigned* bar, unsigned x, unsigned& nloc, unsigned& nx) {
    const unsigned G = gridDim.x * gridDim.y * gridDim.z;
    unsigned sum, cnt, mine, sp = 0u;
    for (;;) {
        sum = 0u; cnt = 0u; mine = 0u;
#pragma unroll
        for (unsigned j = 0; j < 16; ++j) { const unsigned c = xb_ld(&bar[XB_XCNT(j)]); sum += c; cnt += (c > 0u) ? 1u : 0u; mine = (j == x) ? c : mine; }
        if (sum == G) break;
        __builtin_amdgcn_s_sleep(1);
        if ((++sp & 255u) == 0u) { if (xb_ld(&bar[XB_TMO])) break; if (sp > XB_SPIN_CAP) { atomicAdd(&bar[XB_TMO], 1u); break; } }
    }
    nloc = mine > 0u ? mine : 1u; nx = cnt > 0u ? cnt : 1u;
}

__device__ __forceinline__ void xcd_barrier(const XcdBarrier& b) {
    asm volatile("s_waitcnt vmcnt(0)" ::: "memory");
    __syncthreads();
    if (threadIdx.x == 0) {
        unsigned* bar = b.bar;
        __builtin_amdgcn_s_waitcnt(0);
        unsigned nloc = b.st[0], nx = b.st[1];
        if (nloc == 0u) { xcd_barrier_complete(bar, b.x, nloc, nx); b.st[0] = nloc; b.st[1] = nx; }
        const unsigned old = xb_add(&bar[XB_XSUB(b.x)], 1u);
        const unsigned gen = old / nloc;
        if (old + 1u == (gen + 1u) * nloc) {
            __builtin_amdgcn_fence(__ATOMIC_RELEASE, "agent");
            asm volatile("s_waitcnt vmcnt(0)" ::: "memory");
            const unsigned og = xb_add(&bar[XB_TOP], 1u);
            const unsigned tg = og / nx;
            if (og + 1u == (tg + 1u) * nx) xb_add(&bar[XB_TOPGEN], 1u);
            else XB_SPIN(xb_ld(&bar[XB_TOPGEN]) == tg, bar);
            __builtin_amdgcn_fence(__ATOMIC_ACQUIRE, "agent");
            xb_add(&bar[XB_XGEN(b.x)], 1u);
            asm volatile("s_waitcnt vmcnt(0)" ::: "memory");
        } else {
            XB_SPIN(xb_ld(&bar[XB_XGEN(b.x)]) == gen, bar);
            __builtin_amdgcn_fence(__ATOMIC_ACQUIRE, "agent");
            asm volatile("s_waitcnt vmcnt(0)" ::: "memory");
        }
    }
    __syncthreads();
}
using pg8::bf16_t; using pg8::bf16x8; using pg8::f32x4; using pg8::u32x4; using pg8::cvt_pk_bf16;
typedef unsigned u32x2 __attribute__((ext_vector_type(2)));
#ifndef SINGLE_LAUNCH
#define SINGLE_LAUNCH 1
#endif
constexpr int D = 1024, DEPTH = 4, FF = 2816;
constexpr int M_ALL = 18432, M_CTX = 2048, M_X = 16384;
constexpr int P1W = 3840, C_QKV = 1024, C_Z = 2560, C_CQ = 3072, C_CKV = 3456, C_ROPE = 3712, C_AB = 3744;
constexpr int LDS_BYTES = 147456;
constexpr int NPHASE = 2 + 16 * DEPTH;

constexpr size_t al256(size_t x) { return (x + 255) & ~(size_t)255; }
constexpr size_t WS_BAR = 0;
constexpr size_t WS_MOD = 16384, SZ_MOD = (size_t)4 * 9 * 9216 * 4;
constexpr size_t WS_ROPE = WS_MOD + SZ_MOD, SZ_ROPE = (size_t)2048 * 16 * 2 * 4;
constexpr size_t WS_W = al256(WS_ROPE + SZ_ROPE);
constexpr size_t W_GU1 = 0, W_D1 = W_GU1 + (size_t)5632 * 1024 * 2, W_GU2 = W_D1 + (size_t)1024 * 2816 * 2, W_D2 = W_GU2 + (size_t)5632 * 1024 * 2;
constexpr size_t W_INA = W_D2 + (size_t)1024 * 2816 * 2, W_ING = W_INA + (size_t)3840 * 1024 * 2, W_BA = W_ING + (size_t)3072 * 1024 * 2;
constexpr size_t W_BB = W_BA + (size_t)1024 * 512 * 2, W_BC = W_BB + (size_t)1024 * 512 * 2, W_OUT = W_BC + (size_t)1024 * 512 * 2;
constexpr size_t W_UQ = W_OUT + (size_t)1024 * 1024 * 2, W_UKV = W_UQ + (size_t)768 * 384 * 2, W_GMS = W_UKV + (size_t)1024 * 256 * 2, SZ_W = W_GMS + (size_t)4 * 128 * 128 * 2;
constexpr size_t WS_H = al256(WS_W + SZ_W), SZ_H = (size_t)M_ALL * 1024 * 4;
constexpr size_t WS_XN = WS_H + SZ_H, SZ_XN = (size_t)M_ALL * 1024 * 2;
constexpr size_t WS_R1 = WS_XN + SZ_XN, SZ_R1 = (size_t)M_ALL * P1W * 2;
constexpr size_t SZ_Y = (size_t)M_ALL * 512 * 2;
constexpr size_t WS_YA = WS_R1 + SZ_R1, WS_YB = WS_YA + SZ_Y, WS_YC = WS_YB + SZ_Y;
constexpr size_t WS_QH = WS_YC + SZ_Y, WS_KH = WS_QH + SZ_Y;
constexpr size_t WS_U = WS_KH + SZ_Y, WS_WB = WS_U + 2 * SZ_Y, WS_QKB = WS_WB + 2 * SZ_Y, SZ_QKB = (size_t)2 * 288 * 4 * 4096 * 2;
constexpr size_t WS_GAM = WS_QKB + SZ_QKB, SZ_GAM = (size_t)2 * 288 * 4 * 64 * 4, WS_O = WS_GAM + SZ_GAM;
constexpr size_t WS_CQN = WS_O + 2 * SZ_Y, WS_CKVN = WS_CQN + (size_t)M_ALL * 384 * 2;
constexpr size_t WS_Q = WS_CKVN + (size_t)M_ALL * 256 * 2, WS_K = WS_Q + (size_t)M_ALL * 768 * 2, WS_V = WS_K + (size_t)M_ALL * 768 * 2;
constexpr size_t WS_END = WS_V + SZ_Y;
static_assert((size_t)M_ALL * 3072 * 2 <= WS_CQN - WS_U, "G alias");
static_assert((size_t)M_ALL * 1024 * 4 <= WS_END - WS_Q, "MACC alias");
static_assert((size_t)16 * 4 * 9 * 9216 * 4 <= SZ_R1, "MODP alias");
static_assert(WS_END < (size_t)672 * 1024 * 1024, "workspace budget");

__device__ __forceinline__ float bf2f(bf16_t b) { return __uint_as_float(((unsigned)b) << 16); }
__device__ __forceinline__ bf16_t f2bf(float f) { unsigned u = __float_as_uint(f); u += 0x7FFFu + ((u >> 16) & 1u); return (bf16_t)(u >> 16); }
__device__ __forceinline__ void unpack8(const u32x4 r, float* f) {
    f[0] = __uint_as_float(r.x << 16); f[1] = __uint_as_float(r.x & 0xffff0000u); f[2] = __uint_as_float(r.y << 16); f[3] = __uint_as_float(r.y & 0xffff0000u);
    f[4] = __uint_as_float(r.z << 16); f[5] = __uint_as_float(r.z & 0xffff0000u); f[6] = __uint_as_float(r.w << 16); f[7] = __uint_as_float(r.w & 0xffff0000u); }
__device__ __forceinline__ u32x4 pack8(const float* v) { u32x4 w; w.x = cvt_pk_bf16(v[0], v[1]); w.y = cvt_pk_bf16(v[2], v[3]); w.z = cvt_pk_bf16(v[4], v[5]); w.w = cvt_pk_bf16(v[6], v[7]); return w; }
__device__ __forceinline__ float wsum(float v) {
#pragma unroll
    for (int o = 32; o >= 1; o >>= 1) v += __shfl_xor(v, o);
    return v; }
__device__ __forceinline__ float silu_f(float x) { return x / (1.f + __expf(-x)); }
__device__ __forceinline__ float sigm_f(float x) { return 1.f / (1.f + __expf(-x)); }
__device__ __forceinline__ float gelu_t(float x) { const float y = 0.7978845608f * (x + 0.044715f * x * x * x); const float e = __expf(2.f * y); return 0.5f * x * (2.f - 2.f / (1.f + e)); }
__device__ __forceinline__ int srow(int r) { return r < M_CTX ? 8 : ((r - M_CTX) >> 11); }
__device__ __forceinline__ bf16x8 mk8(u32x2 lo, u32x2 hi) { u32x4 t; t.x = lo.x; t.y = lo.y; t.z = hi.x; t.w = hi.y; return __builtin_bit_cast(bf16x8, t); }
#define MFMA16(a, b, c) __builtin_amdgcn_mfma_f32_16x16x32_bf16((a), (b), (c), 0, 0, 0)

constexpr int TAB_OFF = LDS_BYTES - 16 - 512;
__device__ __forceinline__ int otid() { int t = threadIdx.x; asm volatile("" : "+v"(t)); return t; }
struct Ctx { const unsigned char* tab;
    __device__ __forceinline__ unsigned char* ptr(int i) const { const unsigned long long v = *(const volatile unsigned long long*)(tab + 8 * i);
        const unsigned lo = __builtin_amdgcn_readfirstlane((unsigned)v), hi = __builtin_amdgcn_readfirstlane((unsigned)(v >> 32)); return (unsigned char*)(((unsigned long long)hi << 32) | lo); }
    __device__ __forceinline__ const float* in(int i) const { return (const float*)ptr(i); }
    __device__ __forceinline__ unsigned char* ws() const { return ptr(31); }
    __device__ __forceinline__ float* out() const { return (float*)ptr(32); }
};
struct EpiSwiGLU {
    static constexpr bool PERM = true, AFTER_DRAIN = false; bf16_t* O;
    __device__ __forceinline__ void operator()(const f32x4 (&acc)[2][2][4][2], const pg8::Unit& u, int wr, int wc, int fr, int fq) const {
        const int row0 = u.pm * 256 + wr * 64 + fr, col0 = u.pn * 128 + wc * 32 + 8 * fq;
#pragma unroll
        for (int ai = 0; ai < 2; ++ai)
#pragma unroll
            for (int m = 0; m < 4; ++m) { bf16_t* p = O + (size_t)(row0 + ai * 128 + m * 16) * FF + col0; float v[8];
#pragma unroll
                for (int j = 0; j < 4; ++j) { v[j] = silu_f(acc[ai][0][m][0][j]) * acc[ai][1][m][0][j]; v[4 + j] = silu_f(acc[ai][0][m][1][j]) * acc[ai][1][m][1][j]; }
                *(u32x4*)p = pack8(v); asm volatile("" ::: "memory"); }
    }
};
struct EpiResid {
    static constexpr bool PERM = false, AFTER_DRAIN = false; const float* Hin; float* Hout; const float* gate; float cs; int soff;
    __device__ __forceinline__ void operator()(const f32x4 (&acc)[2][2][4][2], const pg8::Unit& u, int wr, int wc, int fr, int fq) const {
        const int s = srow(u.pm * 256 + soff); const float* gp = gate + (size_t)s * 9216;
        const int row0 = u.pm * 256 + wr * 64 + fr, col0 = u.pn * 256 + wc * 32 + 4 * fq;
        f32x4 gv[2][2];
#pragma unroll
        for (int bj = 0; bj < 2; ++bj)
#pragma unroll
            for (int n = 0; n < 2; ++n) gv[bj][n] = *(const f32x4*)(gp + col0 + bj * 128 + n * 16) * cs;
#pragma unroll
        for (int ai = 0; ai < 2; ++ai)
#pragma unroll
            for (int m = 0; m < 4; ++m) { const size_t off = (size_t)(row0 + ai * 128 + m * 16) * 1024 + col0;
#pragma unroll
                for (int bj = 0; bj < 2; ++bj)
#pragma unroll
                    for (int n = 0; n < 2; ++n) { const f32x4 h = *(const f32x4*)(Hin + off + bj * 128 + n * 16); *(f32x4*)(Hout + off + bj * 128 + n * 16) = h + gv[bj][n] * acc[ai][bj][m][n]; } asm volatile("" ::: "memory"); }
    }
};
struct EpiStore {
    static constexpr bool PERM = true, AFTER_DRAIN = false; bf16_t* O; int ldc;
    __device__ __forceinline__ void operator()(const f32x4 (&acc)[2][2][4][2], const pg8::Unit& u, int wr, int wc, int fr, int fq) const {
        const int row0 = u.pm * 256 + wr * 64 + fr, col0 = u.pn * 256 + wc * 32 + 8 * fq;
#pragma unroll
        for (int ai = 0; ai < 2; ++ai)
#pragma unroll
            for (int m = 0; m < 4; ++m)
#pragma unroll
                for (int bj = 0; bj < 2; ++bj) { float v[8];
#pragma unroll
                    for (int j = 0; j < 4; ++j) { v[j] = acc[ai][bj][m][0][j]; v[4 + j] = acc[ai][bj][m][1][j]; }
                    *(u32x4*)(O + (size_t)(row0 + ai * 128 + m * 16) * ldc + col0 + bj * 128) = pack8(v); asm volatile("" ::: "memory"); }
    }
};
struct EpiKV {
    static constexpr bool PERM = true, AFTER_DRAIN = false; bf16_t* K; bf16_t* V;
    __device__ __forceinline__ void operator()(const f32x4 (&acc)[2][2][4][2], const pg8::Unit& u, int wr, int wc, int fr, int fq) const {
        const int row0 = u.pm * 256 + wr * 64 + fr, col0 = u.pn * 256 + wc * 32 + 8 * fq; const bool isk = u.pn < 2;
        bf16_t* base = isk ? K : V; const int pitch = isk ? 768 : 512;
#pragma unroll
        for (int ai = 0; ai < 2; ++ai)
#pragma unroll
            for (int m = 0; m < 4; ++m) { bf16_t* rp = base + (size_t)(row0 + ai * 128 + m * 16) * pitch;
#pragma unroll
                for (int bj = 0; bj < 2; ++bj) { float v[8];
#pragma unroll
                    for (int j = 0; j < 4; ++j) { v[j] = acc[ai][bj][m][0][j]; v[4 + j] = acc[ai][bj][m][1][j]; }
                    const int c = col0 + bj * 128; const int co = isk ? ((c >> 6) * 96 + (c & 63)) : (c - 512);
                    *(u32x4*)(rp + co) = pack8(v); }
                asm volatile("" ::: "memory"); }
    }
};
template <int MODE> struct EpiMerge {
    static constexpr bool PERM = false, AFTER_DRAIN = false; const bf16_t* G; float* MACC; bf16_t* MB;
    __device__ __forceinline__ void operator()(const f32x4 (&acc)[2][2][4][2], const pg8::Unit& u, int wr, int wc, int fr, int fq) const {
        const int row0 = u.pm * 256 + wr * 64 + fr, col0 = u.pn * 256 + wc * 32 + 4 * fq;
#pragma unroll
        for (int ai = 0; ai < 2; ++ai)
#pragma unroll
            for (int m = 0; m < 4; ++m) { const size_t row = (size_t)(row0 + ai * 128 + m * 16);
#pragma unroll
                for (int bj = 0; bj < 2; ++bj)
#pragma unroll
                    for (int n = 0; n < 2; ++n) { const int c = col0 + bj * 128 + n * 16;
                        const u32x2 gr = *(const u32x2*)(G + row * 3072 + c);
                        f32x4 sg; sg[0] = sigm_f(__uint_as_float(gr.x << 16)); sg[1] = sigm_f(__uint_as_float(gr.x & 0xffff0000u)); sg[2] = sigm_f(__uint_as_float(gr.y << 16)); sg[3] = sigm_f(__uint_as_float(gr.y & 0xffff0000u));
                        f32x4 v = sg * acc[ai][bj][m][n];
                        if (MODE >= 1) v += *(const f32x4*)(MACC + row * 1024 + c);
                        if (MODE <= 1) *(f32x4*)(MACC + row * 1024 + c) = v;
                        else { u32x2 w; w.x = cvt_pk_bf16(v[0], v[1]); w.y = cvt_pk_bf16(v[2], v[3]); *(u32x2*)(MB + row * 1024 + c) = w; } }
                asm volatile("" ::: "memory"); }
    }
};
struct Args { const float* in[31]; float* out; unsigned char* ws; int ph_lo, ph_hi; };

template <int MAPID> __device__ __forceinline__ int wmap(int n) {
    if (MAPID == 0) return n;
    if (MAPID == 1) { const int pn = n >> 8, r = n & 255; return (r < 128 ? 0 : 2816) + pn * 128 + (r & 127); }
    if (MAPID == 2) { if (n < 3072) return n; if (n < 3456) return 3088 + (n - 3072); if (n < 3744) return 3472 + (n - 3456); if (n < 3760) return 3072 + (n - 3744); return -1; }
    if (MAPID == 3) return 3760 + n;
    { const int h = (n & 511) >> 6, d = n & 63; return h * 128 + (n >= 512 ? 64 : 0) + d; }
}
template <int MAPID> __device__ __forceinline__ void cvt_t(const float* __restrict__ W, int Nsrc, int K, bf16_t* __restrict__ Wt, int Ndst, float* tile) {
    const int tid = otid(); const int ntn = Ndst >> 6, ntk = K >> 6;
    for (int t = blockIdx.x; t < ntn * ntk; t += gridDim.x) {
        const int tn = t % ntn, tk = t / ntn, n0 = tn * 64, k0 = tk * 64;
#pragma unroll
        for (int p = 0; p < 2; ++p) { const int kk = (tid >> 4) + 32 * p, nq = (tid & 15) * 4; const int src = wmap<MAPID>(n0 + nq);
            float4 v = make_float4(0.f, 0.f, 0.f, 0.f); if (src >= 0) v = *(const float4*)(W + (size_t)(k0 + kk) * Nsrc + src);
            float* tp = tile + kk * 65 + nq; tp[0] = v.x; tp[1] = v.y; tp[2] = v.z; tp[3] = v.w; }
        __syncthreads();
        { const int n = tid >> 3, ko = (tid & 7) * 8; float v[8];
#pragma unroll
          for (int j = 0; j < 8; ++j) v[j] = tile[(ko + j) * 65 + n];
          *(u32x4*)(Wt + (size_t)(n0 + n) * K + k0 + ko) = pack8(v); }
        __syncthreads();
    }
}
__device__ __forceinline__ void convert_layer(const Ctx& a, int l, float* tile) {
    unsigned char* W = a.ws() + WS_W;
    cvt_t<1>(a.in(7) + (size_t)l * 1024 * 5632, 5632, 1024, (bf16_t*)(W + W_GU1), 5632, tile);
    cvt_t<0>(a.in(8) + (size_t)l * 2816 * 1024, 1024, 2816, (bf16_t*)(W + W_D1), 1024, tile);
    cvt_t<1>(a.in(29) + (size_t)l * 1024 * 5632, 5632, 1024, (bf16_t*)(W + W_GU2), 5632, tile);
    cvt_t<0>(a.in(30) + (size_t)l * 2816 * 1024, 1024, 2816, (bf16_t*)(W + W_D2), 1024, tile);
    cvt_t<2>(a.in(10) + (size_t)l * 1024 * 6832, 6832, 1024, (bf16_t*)(W + W_INA), 3840, tile);
    cvt_t<3>(a.in(10) + (size_t)l * 1024 * 6832, 6832, 1024, (bf16_t*)(W + W_ING), 3072, tile);
    cvt_t<0>(a.in(24) + (size_t)l * 512 * 1024, 1024, 512, (bf16_t*)(W + W_BA), 1024, tile);
    cvt_t<0>(a.in(25) + (size_t)l * 512 * 1024, 1024, 512, (bf16_t*)(W + W_BB), 1024, tile);
    cvt_t<0>(a.in(26) + (size_t)l * 512 * 1024, 1024, 512, (bf16_t*)(W + W_BC), 1024, tile);
    cvt_t<0>(a.in(27) + (size_t)l * 1024 * 1024, 1024, 1024, (bf16_t*)(W + W_OUT), 1024, tile);
    cvt_t<0>(a.in(19) + (size_t)l * 384 * 768, 768, 384, (bf16_t*)(W + W_UQ), 768, tile);
    cvt_t<4>(a.in(21) + (size_t)l * 256 * 1024, 1024, 256, (bf16_t*)(W + W_UKV), 1024, tile);
    { const float* src = a.in(12) + (size_t)l * 65536; bf16_t* dst = (bf16_t*)(W + W_GMS);
      for (int i = blockIdx.x * 512 + otid(); i < 65536; i += gridDim.x * 512) dst[i] = f2bf(src[i]); }
}
__device__ __forceinline__ void p0_prologue(const Ctx& a, unsigned char* smem) {
    const int tid = otid(), gtid = blockIdx.x * 512 + tid, gsz = gridDim.x * 512;
    { const float4* c4 = (const float4*)a.in(2); const float4* x4 = (const float4*)a.in(0); float4* h4 = (float4*)(a.ws() + WS_H);
      const int nc = M_CTX * 256, nt = M_ALL * 256;
      for (int i = gtid; i < nt; i += gsz) h4[i] = i < nc ? c4[i] : x4[i - nc]; }
    { float* rt = (float*)(a.ws() + WS_ROPE);
      for (int i = gtid; i < 2048 * 16; i += gsz) { const int t = i >> 4, an = i & 15; const float pos = (float)(an < 8 ? (t >> 6) : (t & 63));
          const float inv = exp2f(-(float)(2 * (an & 7)) * (13.287712379549449f / 16.0f)); const float ang = pos * inv; rt[2 * i] = __cosf(ang); rt[2 * i + 1] = __sinf(ang); } }
    { float* sc = (float*)smem;
      for (int i = tid; i < 9216; i += 512) { const int s = i >> 10, k = i & 1023; const float c = s < 8 ? a.in(1)[s * 1024 + k] : a.in(3)[k]; sc[i] = silu_f(c); }
      __syncthreads();
      float* modp = (float*)(a.ws() + WS_R1);
      for (int idx = gtid; idx < 4 * 16 * 2304; idx += gsz) { const int l = idx / (16 * 2304), rem = idx % (16 * 2304), kc = rem / 2304, cq = rem % 2304;
          f32x4 acc[9];
#pragma unroll
          for (int s = 0; s < 9; ++s) acc[s] = (f32x4){0.f, 0.f, 0.f, 0.f};
          const float* wp = a.in(4) + ((size_t)l * 1024 + kc * 64) * 9216 + 4 * cq;
          for (int kk = 0; kk < 64; ++kk) { const f32x4 w = *(const f32x4*)(wp + (size_t)kk * 9216);
#pragma unroll
              for (int s = 0; s < 9; ++s) acc[s] += sc[s * 1024 + kc * 64 + kk] * w; }
#pragma unroll
          for (int s = 0; s < 9; ++s) *(f32x4*)(modp + ((size_t)((kc * 4 + l) * 9 + s)) * 9216 + 4 * cq) = acc[s]; }
      __syncthreads(); }
    convert_layer(a, 0, (float*)smem);
}
__device__ __forceinline__ void p1_mods(const Ctx& a) {
    const float* modp = (const float*)(a.ws() + WS_R1); float* mod = (float*)(a.ws() + WS_MOD);
    for (int idx = blockIdx.x * 512 + otid(); idx < 4 * 9 * 9216; idx += gridDim.x * 512) { const int l = idx / (9 * 9216), n = idx % 9216;
        float v = a.in(5)[l * 9216 + n];
#pragma unroll
        for (int kc = 0; kc < 16; ++kc) v += modp[(size_t)kc * (4 * 9 * 9216) + idx];
        mod[idx] = v; }
}
__device__ __forceinline__ void norm_phase(const float* __restrict__ H, bf16_t* __restrict__ XN, const float* __restrict__ nw, const float* __restrict__ modl, int shift_i, int scale_i, int r_begin) {
    const int lane = otid() & 63, gw = blockIdx.x * 8 + (otid() >> 6);
    for (int r = r_begin + gw; r < M_ALL; r += gridDim.x * 8) {
        const float* mp = modl + (size_t)srow(r) * 9216; const f32x4* h4 = (const f32x4*)(H + (size_t)r * 1024);
        f32x4 v[4]; float ss = 0.f;
#pragma unroll
        for (int i = 0; i < 4; ++i) { v[i] = h4[i * 64 + lane]; ss += v[i][0] * v[i][0] + v[i][1] * v[i][1] + v[i][2] * v[i][2] + v[i][3] * v[i][3]; }
        ss = wsum(ss); const float rstd = rsqrtf(ss * (1.0f / 1024.0f) + 1e-6f);
#pragma unroll
        for (int i = 0; i < 4; ++i) { const int k = (i * 64 + lane) * 4; const f32x4 w = *(const f32x4*)(nw + k), sc = *(const f32x4*)(mp + scale_i * 1024 + k), sh = *(const f32x4*)(mp + shift_i * 1024 + k);
            const f32x4 o = (v[i] * rstd * w) * (sc + 1.0f) + sh; u32x2 pk; pk.x = cvt_pk_bf16(o[0], o[1]); pk.y = cvt_pk_bf16(o[2], o[3]); *(u32x2*)(XN + (size_t)r * 1024 + k) = pk; }
    }
}
__device__ __forceinline__ void gmlp_item(const Ctx& a, int l, int cidx, int g, unsigned char* smem) {
    const int tid = otid(), lane = tid & 63, wid = tid >> 6, l15 = lane & 15, lg = lane >> 4;
    const bf16_t* P1 = (const bf16_t*)(a.ws() + WS_R1); bf16_t* YA = (bf16_t*)(a.ws() + WS_YA);
    const bf16_t* WsB = (const bf16_t*)(a.ws() + WS_W + W_GMS) + (size_t)g * 16384;
    const float* lnw = a.in(11) + l * 512; const float* bs = a.in(13) + l * 512 + g * 128;
    bf16_t* Vt = (bf16_t*)smem; const int r0 = cidx * 128;
    for (int rr = 0; rr < 16; ++rr) { const int row = wid * 16 + rr;
        const u32x4 raw = *(const u32x4*)(P1 + (size_t)(r0 + row) * P1W + 512 + 8 * lane); float x[8]; unpack8(raw, x); float s = 0.f;
#pragma unroll
        for (int j = 0; j < 8; ++j) { x[j] = gelu_t(x[j]); s += x[j]; }
        const float mean = wsum(s) * (1.0f / 512.0f); float q = 0.f;
#pragma unroll
        for (int j = 0; j < 8; ++j) { x[j] -= mean; q += x[j] * x[j]; }
        const float rstd = rsqrtf(wsum(q) * (1.0f / 512.0f) + 1e-6f);
        if (lg == g) { const int c0 = 8 * l15;
#pragma unroll
            for (int j = 0; j < 8; ++j) Vt[(c0 + j) * 136 + row] = f2bf(x[j] * rstd * lnw[g * 128 + c0 + j]); } }
    __syncthreads();
    f32x4 acc[8];
#pragma unroll
    for (int nt = 0; nt < 8; ++nt) acc[nt] = (f32x4){0.f, 0.f, 0.f, 0.f};
#pragma unroll
    for (int kk = 0; kk < 4; ++kk) { const bf16x8 af = *(const bf16x8*)(WsB + (size_t)(16 * wid + l15) * 128 + 32 * kk + 8 * lg);
#pragma unroll
        for (int nt = 0; nt < 8; ++nt) { const bf16x8 bfr = *(const bf16x8*)(Vt + (16 * nt + l15) * 136 + 32 * kk + 8 * lg); acc[nt] = MFMA16(af, bfr, acc[nt]); } }
#pragma unroll
    for (int nt = 0; nt < 8; ++nt)
#pragma unroll
        for (int r = 0; r < 4; ++r) { const int p = 16 * wid + 4 * lg + r, c = 16 * nt + l15;
            const float uv = gelu_t(bf2f(P1[(size_t)(r0 + p) * P1W + g * 128 + c])); YA[(size_t)(r0 + p) * 512 + g * 128 + c] = f2bf(uv * (acc[nt][r] + bs[p])); }
    __syncthreads();
}
__device__ __forceinline__ void delta_local_item(const Ctx& a, int l, int ci, int hh, unsigned char* smem) {
    const int tid = otid(), lane = tid & 63, wid = tid >> 6, l15 = lane & 15, lg = lane >> 4;
    const bf16_t* P1 = (const bf16_t*)(a.ws() + WS_R1);
    bf16_t* QH = (bf16_t*)(a.ws() + WS_QH); bf16_t* KH = (bf16_t*)(a.ws() + WS_KH); bf16_t* U = (bf16_t*)(a.ws() + WS_U); bf16_t* WB = (bf16_t*)(a.ws() + WS_WB);
    bf16_t* QKB = (bf16_t*)(a.ws() + WS_QKB); float* GAM = (float*)(a.ws() + WS_GAM);
    bf16_t* qs = (bf16_t*)smem; bf16_t* ks = (bf16_t*)(smem + 17408); bf16_t* vs = (bf16_t*)(smem + 34816);
    float* KKs = (float*)(smem + 52224); float* QKs = (float*)(smem + 68608); float* Md = (float*)(smem + 84992);
    float* gm = (float*)(smem + 117760); float* bt = (float*)(smem + 118272); float* bte = (float*)(smem + 118784);
    const int r0 = ci * 64; const int sstart = r0 < M_CTX ? (r0 & ~255) : (M_CTX + ((r0 - M_CTX) & ~2047)); const int send = sstart + (r0 < M_CTX ? 256 : 2048);
    for (int which = 0; which < 3; ++which) { const int ch = which * 512 + hh * 128 + 2 * lane; const float* cw = a.in(14) + (size_t)l * 5 * 1536 + ch;
        float w0[5], w1[5];
#pragma unroll
        for (int j = 0; j < 5; ++j) { w0[j] = cw[j * 1536]; w1[j] = cw[j * 1536 + 1]; }
        for (int tt = 0; tt < 8; ++tt) { const int t = wid * 8 + tt; float a0 = 0.f, a1 = 0.f;
#pragma unroll
            for (int j = 0; j < 5; ++j) { const int rr = r0 + t + j - 2; if (rr >= sstart && rr < send) { const unsigned raw = *(const unsigned*)(P1 + (size_t)rr * P1W + C_QKV + ch);
                a0 += w0[j] * __uint_as_float(raw << 16); a1 += w1[j] * __uint_as_float(raw & 0xffff0000u); } }
            float v0 = silu_f(a0), v1 = silu_f(a1);
            if (which < 2) { const float ss = wsum(v0 * v0 + v1 * v1); const float sc = rsqrtf(ss + 1e-6f) * (which == 0 ? 0.08838834764831845f : 1.0f); v0 *= sc; v1 *= sc; }
            const unsigned pk = cvt_pk_bf16(v0, v1); bf16_t* ld = which == 0 ? qs : (which == 1 ? ks : vs); *(unsigned*)(ld + t * 136 + 2 * lane) = pk;
            if (which == 0) *(unsigned*)(QH + (size_t)(r0 + t) * 512 + hh * 128 + 2 * lane) = pk; else if (which == 1) *(unsigned*)(KH + (size_t)(r0 + t) * 512 + hh * 128 + 2 * lane) = pk; } }
    if (wid < 2) { const int d = wid, i = lane, t = d ? 63 - i : i; const bf16_t* ab = P1 + (size_t)(r0 + t) * P1W + C_AB;
        const float av = bf2f(ab[d * 4 + hh]), bp = bf2f(ab[8 + d * 4 + hh]); const float x = av + a.in(16)[l * 8 + d * 4 + hh];
        const float sp = x > 15.f ? x : __logf(1.0f + __expf(x)); float gv = -__expf(a.in(15)[l * 8 + d * 4 + hh]) * sp;
#pragma unroll
        for (int off = 1; off < 64; off <<= 1) { const float o = __shfl_up(gv, off); if (lane >= off) gv += o; }
        const float b = sigm_f(bp); gm[d * 64 + i] = gv; bt[d * 64 + i] = b; bte[d * 64 + i] = b * __expf(gv); }
    __syncthreads();
    { const int mt = wid >> 1; f32x4 aK[2], aQ[2];
#pragma unroll
      for (int n2 = 0; n2 < 2; ++n2) { aK[n2] = (f32x4){0.f, 0.f, 0.f, 0.f}; aQ[n2] = (f32x4){0.f, 0.f, 0.f, 0.f}; }
#pragma unroll
      for (int kk = 0; kk < 4; ++kk) { const bf16x8 fk = *(const bf16x8*)(ks + (16 * mt + l15) * 136 + 32 * kk + 8 * lg), fq = *(const bf16x8*)(qs + (16 * mt + l15) * 136 + 32 * kk + 8 * lg);
#pragma unroll
          for (int n2 = 0; n2 < 2; ++n2) { const int nt = (wid & 1) * 2 + n2; const bf16x8 fb = *(const bf16x8*)(ks + (16 * nt + l15) * 136 + 32 * kk + 8 * lg);
              aK[n2] = MFMA16(fk, fb, aK[n2]); aQ[n2] = MFMA16(fq, fb, aQ[n2]); } }
#pragma unroll
      for (int n2 = 0; n2 < 2; ++n2) { const int nt = (wid & 1) * 2 + n2;
#pragma unroll
          for (int r = 0; r < 4; ++r) { KKs[(16 * mt + 4 * lg + r) * 64 + 16 * nt + l15] = aK[n2][r]; QKs[(16 * mt + 4 * lg + r) * 64 + 16 * nt + l15] = aQ[n2][r]; } } }
    __syncthreads();
    { const int d = tid >> 8, e0 = tid & 255; const size_t cb = ((size_t)(d * 288 + ci) * 4 + hh);
      for (int n = 0; n < 16; ++n) { const int e = e0 + 256 * n, i = e >> 6, j = e & 63, ti = d ? 63 - i : i, tj = d ? 63 - j : j;
          const float dec = (j <= i) ? __expf(gm[d * 64 + i] - gm[d * 64 + j]) : 0.f;
          Md[d * 4096 + e] = (j < i) ? bt[d * 64 + i] * KKs[ti * 64 + tj] * dec : 0.f;
          QKB[cb * 4096 + e] = f2bf(QKs[ti * 64 + tj] * dec); }
      if (e0 < 64) GAM[cb * 64 + e0] = gm[d * 64 + e0]; }
    __syncthreads();
    { const int d = tid >> 8, col = tid & 255, c = col & 127; const bool isW = col >= 128; const bf16_t* src = isW ? ks : vs; const float* sc = isW ? (bte + d * 64) : (bt + d * 64);
      bf16_t* dst = (isW ? WB : U) + ((size_t)d * M_ALL + r0) * 512 + hh * 128 + c; const float* Mrow = Md + d * 4096;
      float x[64];
#pragma unroll
      for (int i = 0; i < 64; ++i) { const int ti = d ? 63 - i : i; float rhs = bf2f(src[ti * 136 + c]) * sc[i];
#pragma unroll
          for (int j4 = 0; j4 < (i + 3) / 4; ++j4) { const f32x4 m4 = *(const f32x4*)(Mrow + i * 64 + 4 * j4);
              if (4 * j4 + 0 < i) rhs -= m4[0] * x[4 * j4 + 0]; if (4 * j4 + 1 < i) rhs -= m4[1] * x[4 * j4 + 1]; if (4 * j4 + 2 < i) rhs -= m4[2] * x[4 * j4 + 2]; if (4 * j4 + 3 < i) rhs -= m4[3] * x[4 * j4 + 3]; }
          x[i] = rhs; dst[(size_t)i * 512] = f2bf(rhs); asm volatile("" ::: "memory"); } }
    __syncthreads();
}
__device__ __forceinline__ void mla_rows_item(const Ctx& a, int l, int it) {
    const int lane = otid() & 63, r = it * 8 + (otid() >> 6);
    const bf16_t* P1 = (const bf16_t*)(a.ws() + WS_R1) + (size_t)r * P1W; bf16_t* CQN = (bf16_t*)(a.ws() + WS_CQN); bf16_t* CKVN = (bf16_t*)(a.ws() + WS_CKVN);
    { float x[8]; float ss = 0.f; if (lane < 48) { unpack8(*(const u32x4*)(P1 + C_CQ + 8 * lane), x);
#pragma unroll
          for (int j = 0; j < 8; ++j) ss += x[j] * x[j]; }
      const float rstd = rsqrtf(wsum(ss) * (1.0f / 384.0f) + 1e-6f);
      if (lane < 48) { const float* w = a.in(18) + l * 384 + 8 * lane;
#pragma unroll
          for (int j = 0; j < 8; ++j) x[j] = x[j] * rstd * w[j];
          *(u32x4*)(CQN + (size_t)r * 384 + 8 * lane) = pack8(x); } }
    { float x[8]; float ss = 0.f; if (lane < 32) { unpack8(*(const u32x4*)(P1 + C_CKV + 8 * lane), x);
#pragma unroll
          for (int j = 0; j < 8; ++j) ss += x[j] * x[j]; }
      const float rstd = rsqrtf(wsum(ss) * (1.0f / 256.0f) + 1e-6f);
      if (lane < 32) { const float* w = a.in(20) + l * 256 + 8 * lane;
#pragma unroll
          for (int j = 0; j < 8; ++j) x[j] = x[j] * rstd * w[j];
          *(u32x4*)(CKVN + (size_t)r * 256 + 8 * lane) = pack8(x); } }
}
__device__ __forceinline__ void qk_finalize(const Ctx& a, int l) {
    const float* rt = (const float*)(a.ws() + WS_ROPE); const bf16_t* P1 = (const bf16_t*)(a.ws() + WS_R1);
    for (int idx = blockIdx.x * 512 + otid(); idx < 2 * M_ALL * 8; idx += gridDim.x * 512) {
        const int which = idx >= M_ALL * 8, e = which ? idx - M_ALL * 8 : idx, r = e >> 3, h = e & 7;
        bf16_t* p = (bf16_t*)(a.ws() + (which ? WS_K : WS_Q)) + (size_t)r * 768 + h * 96; const float* w = a.in(which ? 23 : 22) + l * 96;
        float x[96];
#pragma unroll
        for (int c = 0; c < 8; ++c) unpack8(*(const u32x4*)(p + 8 * c), x + 8 * c);
        if (which) {
#pragma unroll
            for (int c = 0; c < 4; ++c) unpack8(*(const u32x4*)(P1 + (size_t)r * P1W + C_ROPE + 8 * c), x + 64 + 8 * c); }
        else {
#pragma unroll
            for (int c = 8; c < 12; ++c) unpack8(*(const u32x4*)(p + 8 * c), x + 8 * c); }
        float ss = 0.f;
#pragma unroll
        for (int j = 0; j < 96; ++j) ss += x[j] * x[j];
        const float rstd = rsqrtf(ss * (1.0f / 96.0f) + 1e-6f);
#pragma unroll
        for (int j = 0; j < 96; ++j) x[j] = x[j] * rstd * w[j];
        if (r >= M_CTX) { const int t = (r - M_CTX) & 2047; const float* cs = rt + (size_t)t * 32;
#pragma unroll
            for (int hf = 0; hf < 2; ++hf)
#pragma unroll
                for (int j = 0; j < 8; ++j) { const float c = cs[(hf * 8 + j) * 2], s = cs[(hf * 8 + j) * 2 + 1]; const float x1 = x[64 + hf * 16 + j], x2 = x[64 + hf * 16 + 8 + j];
                    x[64 + hf * 16 + j] = x1 * c - x2 * s; x[64 + hf * 16 + 8 + j] = x2 * c + x1 * s; } }
#pragma unroll
        for (int c = 0; c < 12; ++c) *(u32x4*)(p + 8 * c) = pack8(x + 8 * c);
    }
}
__device__ __forceinline__ void dn_out_phase(const Ctx& a, int l) {
    const int lane = otid() & 63, gw = blockIdx.x * 8 + (otid() >> 6);
    const bf16_t* O = (const bf16_t*)(a.ws() + WS_O); const bf16_t* P1 = (const bf16_t*)(a.ws() + WS_R1); bf16_t* YB = (bf16_t*)(a.ws() + WS_YB); const float* nw = a.in(17) + l * 128 + 8 * (lane & 15);
    for (int r = gw; r < M_ALL; r += gridDim.x * 8) { float o0[8], o1[8], z[8];
        unpack8(*(const u32x4*)(O + (size_t)r * 512 + 8 * lane), o0); unpack8(*(const u32x4*)(O + ((size_t)M_ALL + r) * 512 + 8 * lane), o1); unpack8(*(const u32x4*)(P1 + (size_t)r * P1W + C_Z + 8 * lane), z);
        float ss = 0.f;
#pragma unroll
        for (int j = 0; j < 8; ++j) { o0[j] += o1[j]; ss += o0[j] * o0[j]; }
        ss += __shfl_xor(ss, 1); ss += __shfl_xor(ss, 2); ss += __shfl_xor(ss, 4); ss += __shfl_xor(ss, 8);
        const float rstd = rsqrtf(ss * (1.0f / 128.0f) + 1e-6f);
#pragma unroll
        for (int j = 0; j < 8; ++j) o0[j] = o0[j] * rstd * nw[j] * silu_f(z[j]);
        *(u32x4*)(YB + (size_t)r * 512 + 8 * lane) = pack8(o0); }
}
__device__ __forceinline__ void attn_item(const Ctx& a, int it, unsigned char* smem) {
    const int tid = otid(), lane = tid & 63, wid = tid >> 6, l15 = lane & 15, lg = lane >> 4;
    const bf16_t* Q = (const bf16_t*)(a.ws() + WS_Q); const bf16_t* K = (const bf16_t*)(a.ws() + WS_K); const bf16_t* V = (const bf16_t*)(a.ws() + WS_V); bf16_t* YC = (bf16_t*)(a.ws() + WS_YC);
    int b, head, qrow0, nkt;
    if (it < 1024) { b = it >> 7; head = (it >> 4) & 7; qrow0 = M_CTX + b * 2048 + (it & 15) * 128; nkt = 36; }
    else { const int j = it - 1024; b = j >> 4; head = (j >> 1) & 7; qrow0 = b * 256 + (j & 1) * 128; nkt = 4; }
    const int lat0 = M_CTX + b * 2048, ctx0 = b * 256;
    bf16_t* Ks = (bf16_t*)smem; bf16_t* Vt = (bf16_t*)(smem + 13312);
    bf16x8 qf[3];
    { const bf16_t* qp = Q + (size_t)(qrow0 + wid * 16 + l15) * 768 + head * 96 + 8 * lg;
#pragma unroll
      for (int kk = 0; kk < 3; ++kk) qf[kk] = *(const bf16x8*)(qp + 32 * kk); }
    f32x4 o[4];
#pragma unroll
    for (int i = 0; i < 4; ++i) o[i] = (f32x4){0.f, 0.f, 0.f, 0.f};
    float mrun = -1e30f, lrun = 0.f;
    const float csc = 0.14724445f;
    u32x4 pk0, pk1, pv;
    const int c0 = tid, c1 = tid + 512;
#define ATT_LOAD(kt) do { const int krow0 = (nkt == 36 && (kt) < 32) ? lat0 + (kt) * 64 : ctx0 + ((nkt == 36) ? (kt) - 32 : (kt)) * 64; \
        pk0 = *(const u32x4*)(K + (size_t)(krow0 + c0 / 12) * 768 + head * 96 + (c0 % 12) * 8); \
        if (c1 < 768) pk1 = *(const u32x4*)(K + (size_t)(krow0 + c1 / 12) * 768 + head * 96 + (c1 % 12) * 8); \
        pv = *(const u32x4*)(V + (size_t)(krow0 + (tid >> 3)) * 512 + head * 64 + (tid & 7) * 8); } while (0)
    ATT_LOAD(0);
    for (int kt = 0; kt < nkt; ++kt) {
        __syncthreads();
        *(u32x4*)(Ks + (c0 / 12) * 104 + (c0 % 12) * 8) = pk0; if (c1 < 768) *(u32x4*)(Ks + (c1 / 12) * 104 + (c1 % 12) * 8) = pk1;
        { const int key = tid >> 3, dv0 = (tid & 7) * 8; const unsigned wv[4] = {pv.x, pv.y, pv.z, pv.w};
#pragma unroll
          for (int j = 0; j < 4; ++j) { Vt[(dv0 + 2 * j) * 72 + key] = (bf16_t)(wv[j] & 0xffffu); Vt[(dv0 + 2 * j + 1) * 72 + key] = (bf16_t)(wv[j] >> 16); } }
        __syncthreads();
        if (kt + 1 < nkt) ATT_LOAD(kt + 1);
        f32x4 st[4]; float mx = -1e30f;
#pragma unroll
        for (int mt = 0; mt < 4; ++mt) { st[mt] = (f32x4){0.f, 0.f, 0.f, 0.f};
#pragma unroll
            for (int kk = 0; kk < 3; ++kk) { const bf16x8 kf = *(const bf16x8*)(Ks + (16 * mt + l15) * 104 + 32 * kk + 8 * lg); st[mt] = MFMA16(kf, qf[kk], st[mt]); }
            mx = fmaxf(mx, fmaxf(fmaxf(st[mt][0], st[mt][1]), fmaxf(st[mt][2], st[mt][3]))); }
        mx = fmaxf(mx, __shfl_xor(mx, 16)); mx = fmaxf(mx, __shfl_xor(mx, 32));
        const float mnew = fmaxf(mrun, mx * csc); const float alpha = exp2f(mrun - mnew); mrun = mnew; float ps = 0.f;
#pragma unroll
        for (int mt = 0; mt < 4; ++mt)
#pragma unroll
            for (int r = 0; r < 4; ++r) { const float p = exp2f(st[mt][r] * csc - mnew); st[mt][r] = p; ps += p; }
        lrun = lrun * alpha + ps;
        bf16x8 pf[2];
#pragma unroll
        for (int k2 = 0; k2 < 2; ++k2) { u32x4 t; t.x = cvt_pk_bf16(st[2 * k2][0], st[2 * k2][1]); t.y = cvt_pk_bf16(st[2 * k2][2], st[2 * k2][3]); t.z = cvt_pk_bf16(st[2 * k2 + 1][0], st[2 * k2 + 1][1]); t.w = cvt_pk_bf16(st[2 * k2 + 1][2], st[2 * k2 + 1][3]); pf[k2] = __builtin_bit_cast(bf16x8, t); }
#pragma unroll
        for (int dt = 0; dt < 4; ++dt) { o[dt] *= alpha;
#pragma unroll
            for (int k2 = 0; k2 < 2; ++k2) { const bf16_t* vp = Vt + (16 * dt + l15) * 72 + 32 * k2 + 4 * lg; const bf16x8 vf = mk8(*(const u32x2*)vp, *(const u32x2*)(vp + 16)); o[dt] = MFMA16(vf, pf[k2], o[dt]); } }
    }
#undef ATT_LOAD
    lrun += __shfl_xor(lrun, 16); lrun += __shfl_xor(lrun, 32); const float inv = 1.0f / lrun;
    bf16_t* yp = YC + (size_t)(qrow0 + wid * 16 + l15) * 512 + head * 64 + 4 * lg;
#pragma unroll
    for (int dt = 0; dt < 4; ++dt) { u32x2 w; w.x = cvt_pk_bf16(o[dt][0] * inv, o[dt][1] * inv); w.y = cvt_pk_bf16(o[dt][2] * inv, o[dt][3] * inv); *(u32x2*)(yp + 16 * dt) = w; }
    __syncthreads();
}
__device__ __forceinline__ void scan_seq(const Ctx& a, int sq, unsigned char* smem) {
    const int tid = otid(), lane = tid & 63, wid = tid >> 6, l15 = lane & 15, lg = lane >> 4;
    const int b = sq >> 3, hh = (sq >> 1) & 3, d = sq & 1;
    const bf16_t* QH = (const bf16_t*)(a.ws() + WS_QH); const bf16_t* KH = (const bf16_t*)(a.ws() + WS_KH); const bf16_t* U = (const bf16_t*)(a.ws() + WS_U) + (size_t)d * M_ALL * 512; const bf16_t* WB = (const bf16_t*)(a.ws() + WS_WB) + (size_t)d * M_ALL * 512;
    const bf16_t* QKB = (const bf16_t*)(a.ws() + WS_QKB); const float* GAM = (const float*)(a.ws() + WS_GAM); bf16_t* O = (bf16_t*)(a.ws() + WS_O) + (size_t)d * M_ALL * 512;
    bf16_t* Wl = (bf16_t*)smem; bf16_t* Ql = (bf16_t*)(smem + 17408); bf16_t* Ul = (bf16_t*)(smem + 34816); bf16_t* KT = (bf16_t*)(smem + 52224); bf16_t* QKl = (bf16_t*)(smem + 70656);
    float* eg = (float*)(smem + 79872); float* ev = (float*)(smem + 80128);
    f32x4 sacc[8];
#pragma unroll
    for (int i = 0; i < 8; ++i) sacc[i] = (f32x4){0.f, 0.f, 0.f, 0.f};
    u32x4 pw[2], pq[2], pk[2], pu[2], pqk; float pg = 0.f;
#define SCAN_CI(s) ((s) < 4 ? b * 4 + (d ? 3 - (s) : (s)) : 32 + b * 32 + (d ? 35 - (s) : (s) - 4))
#define SCAN_LOAD(s) do { const int ci_ = SCAN_CI(s); const size_t cb_ = ((size_t)(d * 288 + ci_) * 4 + hh); \
        _Pragma("unroll") for (int p = 0; p < 2; ++p) { const int idx = tid + 512 * p, i = idx >> 4, part = idx & 15; const size_t po = (size_t)(ci_ * 64 + i) * 512 + hh * 128 + part * 8; \
            const size_t to = (size_t)(ci_ * 64 + (d ? 63 - i : i)) * 512 + hh * 128 + part * 8; \
            pw[p] = *(const u32x4*)(WB + po); pu[p] = *(const u32x4*)(U + po); pq[p] = *(const u32x4*)(QH + to); pk[p] = *(const u32x4*)(KH + to); } \
        pqk = *(const u32x4*)(QKB + cb_ * 4096 + tid * 8); if (tid < 64) pg = GAM[cb_ * 64 + tid]; } while (0)
    SCAN_LOAD(0);
    for (int s = 0; s < 36; ++s) {
        const int ci = SCAN_CI(s);
        __syncthreads();
#pragma unroll
        for (int p = 0; p < 2; ++p) { const int idx = tid + 512 * p, i = idx >> 4, part = idx & 15;
            *(u32x4*)(Wl + i * 136 + part * 8) = pw[p]; *(u32x4*)(Ql + i * 136 + part * 8) = pq[p]; *(u32x4*)(Ul + i * 136 + part * 8) = pu[p];
            const unsigned wv[4] = {pk[p].x, pk[p].y, pk[p].z, pk[p].w};
#pragma unroll
            for (int j = 0; j < 4; ++j) { KT[(part * 8 + 2 * j) * 72 + i] = (bf16_t)(wv[j] & 0xffffu); KT[(part * 8 + 2 * j + 1) * 72 + i] = (bf16_t)(wv[j] >> 16); } }
        *(u32x4*)(QKl + (tid >> 3) * 72 + (tid & 7) * 8) = pqk;
        if (tid < 64) { const float gl = __shfl(pg, 63); eg[tid] = __expf(pg); ev[tid] = __expf(gl - pg); }
        __syncthreads();
        if (s + 1 < 36) SCAN_LOAD(s + 1);
        bf16x8 sb[4];
#pragma unroll
        for (int kk = 0; kk < 4; ++kk) { u32x4 t; t.x = cvt_pk_bf16(sacc[2 * kk][0], sacc[2 * kk][1]); t.y = cvt_pk_bf16(sacc[2 * kk][2], sacc[2 * kk][3]); t.z = cvt_pk_bf16(sacc[2 * kk + 1][0], sacc[2 * kk + 1][1]); t.w = cvt_pk_bf16(sacc[2 * kk + 1][2], sacc[2 * kk + 1][3]); sb[kk] = __builtin_bit_cast(bf16x8, t); }
        f32x4 vn[4], oq[4];
#pragma unroll
        for (int mt = 0; mt < 4; ++mt) { f32x4 aw = (f32x4){0.f, 0.f, 0.f, 0.f}, aq = (f32x4){0.f, 0.f, 0.f, 0.f};
#pragma unroll
            for (int kk = 0; kk < 4; ++kk) { const bf16_t* wp = Wl + (16 * mt + l15) * 136 + 32 * kk + 4 * lg; const bf16_t* qp = Ql + (16 * mt + l15) * 136 + 32 * kk + 4 * lg;
                aw = MFMA16(mk8(*(const u32x2*)wp, *(const u32x2*)(wp + 16)), sb[kk], aw); aq = MFMA16(mk8(*(const u32x2*)qp, *(const u32x2*)(qp + 16)), sb[kk], aq); }
#pragma unroll
            for (int r = 0; r < 4; ++r) vn[mt][r] = bf2f(Ul[(16 * mt + 4 * lg + r) * 136 + 16 * wid + l15]) - aw[r];
            oq[mt] = aq; asm volatile("" ::: "memory"); }
        bf16x8 vb[2], vtb[2];
#pragma unroll
        for (int k2 = 0; k2 < 2; ++k2) { u32x4 t, t2; float e0[4], e1[4];
#pragma unroll
            for (int r = 0; r < 4; ++r) { e0[r] = ev[32 * k2 + 4 * lg + r]; e1[r] = ev[32 * k2 + 16 + 4 * lg + r]; }
            t.x = cvt_pk_bf16(vn[2 * k2][0], vn[2 * k2][1]); t.y = cvt_pk_bf16(vn[2 * k2][2], vn[2 * k2][3]); t.z = cvt_pk_bf16(vn[2 * k2 + 1][0], vn[2 * k2 + 1][1]); t.w = cvt_pk_bf16(vn[2 * k2 + 1][2], vn[2 * k2 + 1][3]);
            t2.x = cvt_pk_bf16(vn[2 * k2][0] * e0[0], vn[2 * k2][1] * e0[1]); t2.y = cvt_pk_bf16(vn[2 * k2][2] * e0[2], vn[2 * k2][3] * e0[3]);
            t2.z = cvt_pk_bf16(vn[2 * k2 + 1][0] * e1[0], vn[2 * k2 + 1][1] * e1[1]); t2.w = cvt_pk_bf16(vn[2 * k2 + 1][2] * e1[2], vn[2 * k2 + 1][3] * e1[3]);
            vb[k2] = __builtin_bit_cast(bf16x8, t); vtb[k2] = __builtin_bit_cast(bf16x8, t2); }
#pragma unroll
        for (int mt = 0; mt < 4; ++mt) { f32x4 o2 = (f32x4){0.f, 0.f, 0.f, 0.f};
#pragma unroll
            for (int k2 = 0; k2 < 2; ++k2) { const bf16_t* ap = QKl + (16 * mt + l15) * 72 + 32 * k2 + 4 * lg; o2 = MFMA16(mk8(*(const u32x2*)ap, *(const u32x2*)(ap + 16)), vb[k2], o2); }
#pragma unroll
            for (int r = 0; r < 4; ++r) { const int i = 16 * mt + 4 * lg + r; const float val = eg[i] * oq[mt][r] + o2[r];
                O[(size_t)(ci * 64 + (d ? 63 - i : i)) * 512 + hh * 128 + 16 * wid + l15] = f2bf(val); } asm volatile("" ::: "memory"); }
        const float el = eg[63];
#pragma unroll
        for (int m8 = 0; m8 < 8; ++m8) { f32x4 acc = sacc[m8] * el;
#pragma unroll
            for (int k2 = 0; k2 < 2; ++k2) { const bf16_t* kp = KT + (16 * m8 + l15) * 72 + 32 * k2 + 4 * lg; acc = MFMA16(mk8(*(const u32x2*)kp, *(const u32x2*)(kp + 16)), vtb[k2], acc); }
            sacc[m8] = acc; asm volatile("" ::: "memory"); }
    }
#undef SCAN_LOAD
#undef SCAN_CI
    __syncthreads();
}
#ifndef PHMASK
#define PHMASK 0x3ffff
#endif
#define EN(k) ((PHMASK >> (k)) & 1)
#ifndef SUBMASK
#define SUBMASK 0
#endif
#define SUBOFF(k) ((SUBMASK >> (k)) & 1)
#define RUN_GEMM(EPI, Aptr, Bptr, Mrows, Ncols, Kdim, ...) do { int kd_ = (Kdim); asm volatile("" : "+s"(kd_)); pg8::Gemm g_{(const bf16_t*)(Aptr), (const bf16_t*)(Bptr), (Mrows), (Ncols), kd_}; pg8::StaticOrder S_; S_.init((Mrows), (Ncols), (int)gridDim.x, (int)blockIdx.x); \
        EPI E_{__VA_ARGS__}; pg8::gemm_phase<EPI, pg8::StaticOrder>(lds, g_, S_, E_, nullptr); } while (0)

__global__ void __launch_bounds__(512, 2) fwd_kernel(Args ka) {
    extern __shared__ __attribute__((aligned(16))) unsigned char smem[];
    cg::grid_group grid = cg::this_grid();
    PG8_LAS unsigned char* lds = (PG8_LAS unsigned char*)smem;
    volatile LAS unsigned* stw = (volatile LAS unsigned*)(lds + (LDS_BYTES - 16));
    if (threadIdx.x < 4) stw[threadIdx.x] = 0u;
    { unsigned long long* tab = (unsigned long long*)(smem + TAB_OFF); const int t = threadIdx.x;
      if (t < 31) tab[t] = (unsigned long long)ka.in[t]; else if (t == 31) tab[31] = (unsigned long long)ka.ws; else if (t == 32) tab[32] = (unsigned long long)ka.out; }
    __syncthreads();
    const Ctx a{smem + TAB_OFF};
    XcdBarrier bar = xcd_barrier_post((unsigned*)(a.ws() + WS_BAR), stw);
    const int G = (int)gridDim.x, bid = (int)blockIdx.x;
    const int ph_lo = ka.ph_lo, ph_hi = ka.ph_hi;
    for (int p = ph_lo; p < ph_hi; ++p) {
        unsigned char* ws = a.ws(); unsigned char* W = ws + WS_W;
        float* H = (float*)(ws + WS_H); bf16_t* XN = (bf16_t*)(ws + WS_XN); bf16_t* P1 = (bf16_t*)(ws + WS_R1); bf16_t* ACT = (bf16_t*)(ws + WS_R1);
        bf16_t* GT = (bf16_t*)(ws + WS_U); float* MACC = (float*)(ws + WS_Q); bf16_t* MB = (bf16_t*)(ws + WS_QH);
        if (p == 0) { if (EN(0)) p0_prologue(a, smem); }
        else if (p == 1) { if (EN(1)) p1_mods(a); }
        else {
            const int l = (p - 2) >> 4, j = (p - 2) & 15; const float* modl = (const float*)(ws + WS_MOD) + (size_t)l * 9 * 9216;
            const int ro = (l == DEPTH - 1) ? M_CTX : 0, Mr = M_ALL - ro;
            if (j == 0 && !EN(2)) {} else if (j == 0) { if (!SUBOFF(7)) norm_phase(H, XN, a.in(6) + l * 1024, modl, 0, 1, 0); if (l > 0 && !SUBOFF(8)) convert_layer(a, l, (float*)smem); }
            else if (j == 1 && !EN(3)) {} else if (j == 1) RUN_GEMM(EpiSwiGLU, XN, W + W_GU1, M_ALL, 5632, 1024, ACT);
            else if (j == 2 && !EN(4)) {} else if (j == 2) RUN_GEMM(EpiResid, ACT, W + W_D1, M_ALL, 1024, 2816, H, H, modl + 2 * 1024, 0.5f, 0);
            else if (j == 3 && !EN(5)) {} else if (j == 3) norm_phase(H, XN, a.in(9) + l * 1024, modl, 3, 4, 0);
            else if (j == 4 && !EN(6)) {} else if (j == 4) RUN_GEMM(EpiStore, XN, W + W_INA, M_ALL, 3840, 1024, P1, P1W);
            else if (j == 5 && !EN(7)) {} else if (j == 5) {
                for (int it = bid; it < 1152 + 576 + 2304; it += G) {
                    if (it < 1152) { if (!SUBOFF(0)) delta_local_item(a, l, it >> 2, it & 3, smem); }
                    else if (it < 1728) { if (!SUBOFF(1)) gmlp_item(a, l, (it - 1152) >> 2, (it - 1152) & 3, smem); }
                    else { if (!SUBOFF(2)) mla_rows_item(a, l, it - 1728); } } }
            else if (j == 6 && !EN(8)) {} else if (j == 6) {
                if (!SUBOFF(3)) RUN_GEMM(EpiStore, ws + WS_CQN, W + W_UQ, M_ALL, 768, 384, (bf16_t*)(ws + WS_Q), 768);
                if (!SUBOFF(4)) RUN_GEMM(EpiKV, ws + WS_CKVN, W + W_UKV, M_ALL, 1024, 256, (bf16_t*)(ws + WS_K), (bf16_t*)(ws + WS_V)); }
            else if (j == 7 && !EN(9)) {} else if (j == 7) qk_finalize(a, l);
            else if (j == 8 && !EN(10)) {} else if (j == 8) {
                const int nat = (l < DEPTH - 1) ? 1152 : 1024;
                if (G >= 128) { if (bid < 64) { if (!SUBOFF(5)) scan_seq(a, bid, smem); } else for (int it = bid - 64; it < nat; it += G - 64) { if (!SUBOFF(6)) attn_item(a, it, smem); } }
                else { for (int sq = bid; sq < 64; sq += G) { if (!SUBOFF(5)) scan_seq(a, sq, smem); } for (int it = bid; it < nat; it += G) { if (!SUBOFF(6)) attn_item(a, it, smem); } } }
            else if (j == 9 && !EN(11)) {} else if (j == 9) dn_out_phase(a, l);
            else if (j == 10 && !EN(12)) {} else if (j == 10) RUN_GEMM(EpiStore, XN + (size_t)ro * 1024, W + W_ING, Mr, 3072, 1024, GT + (size_t)ro * 3072, 3072);
            else if (j == 11 && !EN(13)) {} else if (j == 11) {
                RUN_GEMM(EpiMerge<0>, ws + WS_YA + (size_t)ro * 1024, W + W_BA, Mr, 1024, 512, GT + (size_t)ro * 3072, MACC + (size_t)ro * 1024, MB + (size_t)ro * 1024);
                RUN_GEMM(EpiMerge<1>, ws + WS_YB + (size_t)ro * 1024, W + W_BB, Mr, 1024, 512, GT + (size_t)ro * 3072 + 1024, MACC + (size_t)ro * 1024, MB + (size_t)ro * 1024);
                RUN_GEMM(EpiMerge<2>, ws + WS_YC + (size_t)ro * 1024, W + W_BC, Mr, 1024, 512, GT + (size_t)ro * 3072 + 2048, MACC + (size_t)ro * 1024, MB + (size_t)ro * 1024); }
            else if (j == 12 && !EN(14)) {} else if (j == 12) RUN_GEMM(EpiResid, MB + (size_t)ro * 1024, W + W_OUT, Mr, 1024, 1024, H + (size_t)ro * 1024, H + (size_t)ro * 1024, modl + 5 * 1024, 1.0f, ro);
            else if (j == 13 && !EN(15)) {} else if (j == 13) norm_phase(H, XN, a.in(28) + l * 1024, modl, 6, 7, ro);
            else if (j == 14 && !EN(16)) {} else if (j == 14) RUN_GEMM(EpiSwiGLU, XN + (size_t)ro * 1024, W + W_GU2, Mr, 5632, 1024, ACT + (size_t)ro * FF);
            else if (!EN(17)) {} else RUN_GEMM(EpiResid, ACT + (size_t)ro * FF, W + W_D2, Mr, 1024, 2816, H + (size_t)ro * 1024, (l == DEPTH - 1) ? a.out() : H + (size_t)ro * 1024, modl + 8 * 1024, 0.5f, ro);
        }
        if (p + 1 < ph_hi) { if (p == ph_lo) grid.sync(); else xcd_barrier(bar); }
    }
}

extern "C" void kernel_launch(void* const* d_in, const int* in_sizes, int n_in, void* d_out, int out_size, void* d_ws, size_t ws_size, hipStream_t stream) {
    static int grid = 0;
    if (grid == 0) {
        int dev = 0, cus = 0, per_cu = 0;
        hipGetDevice(&dev); hipDeviceGetAttribute(&cus, hipDeviceAttributeMultiprocessorCount, dev);
        if (hipFuncSetAttribute((const void*)fwd_kernel, hipFuncAttributeMaxDynamicSharedMemorySize, LDS_BYTES) != hipSuccess) { fprintf(stderr, "hipFuncSetAttribute failed\n"); }
        if (hipOccupancyMaxActiveBlocksPerMultiprocessor(&per_cu, (const void*)fwd_kernel, 512, LDS_BYTES) != hipSuccess || per_cu < 1) { fprintf(stderr, "occupancy query: %d\n", per_cu); per_cu = 1; }
        (void)hipGetLastError();
        grid = cus;
        if (ws_size < WS_END) { fprintf(stderr, "workspace too small: %zu < %zu\n", ws_size, (size_t)WS_END); grid = -1; }
        if (n_in != 31) { fprintf(stderr, "expected 31 inputs\n"); grid = -1; }
        else { const long long L = 4, ex[31] = {8LL*2048*1024, 8*1024, 8LL*256*1024, 1024, L*1024*9216, L*9216, L*1024, L*1024*5632, L*2816*1024, L*1024, L*1024*6832, L*512, L*4*128*128, L*4*128, L*5*1536, L*8, L*8, L*128,
                  L*384, L*384*768, L*256, L*256*1024, L*96, L*96, L*512*1024, L*512*1024, L*512*1024, L*1024*1024, L*1024, L*1024*5632, L*2816*1024};
               for (int i = 0; i < 31; ++i) if ((long long)in_sizes[i] != ex[i]) { fprintf(stderr, "input %d: size %d, expected %lld\n", i, in_sizes[i], ex[i]); grid = -1; } }
    }
    if (grid < 0) return;
    hipMemsetAsync((char*)d_ws + WS_BAR, 0, 16384, stream);
    Args a{};
    for (int i = 0; i < 31; ++i) a.in[i] = (const float*)d_in[i];
    a.out = (float*)d_out; a.ws = (unsigned char*)d_ws;
#if SINGLE_LAUNCH
    a.ph_lo = 0; a.ph_hi = NPHASE;
    { void* args[] = {&a}; hipError_t e = hipLaunchCooperativeKernel((const void*)fwd_kernel, dim3(grid), dim3(512), args, LDS_BYTES, stream);
      if (e != hipSuccess) fprintf(stderr, "cooperative launch failed: %s (grid %d)\n", hipGetErrorString(e), grid); }
#else
    for (int p = 0; p < NPHASE; ++p) { a.ph_lo = p; a.ph_hi = p + 1; void* args[] = {&a};
        hipError_t e = hipLaunchCooperativeKernel((const void*)fwd_kernel, dim3(grid), dim3(512), args, LDS_BYTES, stream);
        if (e != hipSuccess) { fprintf(stderr, "launch %d failed: %s\n", p, hipGetErrorString(e)); break; } }
#endif
}
```
